# Optimizing an MI355X kernel written in HIP

```python
import math
import jax, jax.numpy as jnp
from jax import lax
import numpy as np

D_MODEL = 2048
BATCH = 8
SEQ = 2048
DEPTH = 1

MLSTM_WIDTH = D_MODEL // 2
MLSTM_HEADS = 4
MLSTM_V_DIM = MLSTM_WIDTH // MLSTM_HEADS
MLSTM_QK_DIM = MLSTM_V_DIM // 2
MLSTM_CHUNK = 64
CONV_WIDTH = 4
S5_WIDTH = D_MODEL - MLSTM_WIDTH
S5_GROUP = 16
S5_GROUPS = S5_WIDTH // S5_GROUP
S5_STATE = 64
DT_MIN = 1e-3
DT_MAX = 1e-1
D_MIX = MLSTM_WIDTH + S5_WIDTH
QK_COLS = 2 * MLSTM_HEADS * MLSTM_QK_DIM
V_COLS = MLSTM_HEADS * MLSTM_V_DIM
O_COLS = MLSTM_WIDTH
GATE_COLS = MLSTM_HEADS
IN_COLS = QK_COLS + V_COLS + O_COLS + 2 * GATE_COLS + S5_WIDTH
D_FF = ((8 * D_MODEL // 3 + 255) // 256) * 256
EPS = 1e-6

kernel_name = "macaron_mlstm_s5_hybrid"


def rms_norm(x, g):
    xf = x.astype(jnp.float32)
    y = xf * lax.rsqrt(jnp.mean(xf * xf, axis=-1, keepdims=True) + EPS)
    return (y * g.astype(jnp.float32)).astype(x.dtype)


def swiglu(x, w1, w3, w2):
    return (jax.nn.silu(x @ w1) * (x @ w3)) @ w2


def causal_depthwise_conv(x, w, b):
    k = w.shape[0]
    c = x.shape[-1]
    y = lax.conv_general_dilated(x, w[:, None, :], window_strides=(1,), padding=[(k - 1, 0)],
                                 dimension_numbers=('NWC', 'WIO', 'NWC'), feature_group_count=c)
    return y + b


def mlstm_chunkwise(q, k, v, i_pre, f_pre):
    bsz, seq, nh, dk = q.shape
    dv = v.shape[-1]
    nc = seq // MLSTM_CHUNK
    L = MLSTM_CHUNK

    def to_chunks(a):
        return a.reshape(bsz, nc, L, nh, a.shape[-1]).transpose(0, 3, 1, 2, 4)

    q = to_chunks(q) * (dk ** -0.5)
    k = to_chunks(k)
    v = to_chunks(v)
    li = i_pre.reshape(bsz, nc, L, nh).transpose(0, 3, 1, 2)
    lf = jax.nn.log_sigmoid(f_pre).reshape(bsz, nc, L, nh).transpose(0, 3, 1, 2)
    b = jnp.cumsum(lf, axis=-1)
    b_end = b[..., -1]

    w_end = b_end[..., None] - b + li
    m_loc = jnp.max(w_end, axis=-1)
    e_end = jnp.exp(w_end - m_loc[..., None])
    c_loc = jnp.einsum('bhcs,bhcsv,bhcsk->bhcvk', e_end, v, k)
    n_loc = jnp.einsum('bhcs,bhcsk->bhck', e_end, k)

    def step(carry, inp):
        c_st, n_st, m_st = carry
        c_l, n_l, m_l, bl = inp
        m_new = jnp.maximum(bl + m_st, m_l)
        a = jnp.exp(bl + m_st - m_new)
        g = jnp.exp(m_l - m_new)
        c_new = a[..., None, None] * c_st + g[..., None, None] * c_l
        n_new = a[..., None] * n_st + g[..., None] * n_l
        return (c_new, n_new, m_new), (c_st, n_st, m_st)

    init = (jnp.zeros((bsz, nh, dv, dk), jnp.float32),
            jnp.zeros((bsz, nh, dk), jnp.float32),
            jnp.zeros((bsz, nh), jnp.float32))
    xs = (jnp.moveaxis(c_loc, 2, 0), jnp.moveaxis(n_loc, 2, 0),
          jnp.moveaxis(m_loc, 2, 0), jnp.moveaxis(b_end, 2, 0))
    _, (c_prev, n_prev, m_prev) = lax.scan(step, init, xs)
    c_prev = jnp.moveaxis(c_prev, 0, 2)
    n_prev = jnp.moveaxis(n_prev, 0, 2)
    m_prev = jnp.moveaxis(m_prev, 0, 2)

    causal = jnp.tril(jnp.ones((L, L), dtype=bool))
    log_d = jnp.where(causal, b[..., :, None] - b[..., None, :] + li[..., None, :], -jnp.inf)
    inter_log = b + m_prev[..., None]
    m_t = jnp.maximum(inter_log, jnp.max(log_d, axis=-1))
    d_mat = jnp.exp(log_d - m_t[..., None])
    a_t = jnp.exp(inter_log - m_t)

    s = jnp.einsum('bhctk,bhcsk->bhcts', q, k) * d_mat
    num = jnp.einsum('bhcts,bhcsv->bhctv', s, v) + a_t[..., None] * jnp.einsum('bhctk,bhcvk->bhctv', q, c_prev)
    den = jnp.sum(s, axis=-1) + a_t * jnp.einsum('bhctk,bhck->bhct', q, n_prev)
    h = num / jnp.maximum(jnp.abs(den), jnp.exp(-m_t))[..., None]
    return h.transpose(0, 2, 3, 1, 4).reshape(bsz, seq, nh, dv)


def s5_branch(u, lam_re, lam_im, log_dt, b_re, b_im, c_re, c_im, d_skip, w_glu, b_glu):
    bsz, seq, _ = u.shape
    f32 = jnp.float32
    uf = u.astype(f32).reshape(bsz, seq, S5_GROUPS, S5_GROUP)
    lam = lax.complex(lam_re.astype(f32), lam_im.astype(f32))
    dt = jnp.exp(log_dt.astype(f32))[:, None]
    lam_bar = jnp.exp(lam * dt)
    b_c = lax.complex(b_re.astype(f32), b_im.astype(f32))
    b_bar = ((lam_bar - 1.0) / lam)[..., None] * b_c
    bu = jnp.einsum('bsgh,gph->bsgp', uf.astype(jnp.complex64), b_bar)
    a = jnp.broadcast_to(lam_bar[None, None], (1, seq, S5_GROUPS, S5_STATE))

    def combine(e1, e2):
        a1, x1 = e1
        a2, x2 = e2
        return a1 * a2, a2 * x1 + x2

    _, states = lax.associative_scan(combine, (a, bu), axis=1)
    c_c = lax.complex(c_re.astype(f32), c_im.astype(f32))
    y = jnp.real(jnp.einsum('bsgp,ghp->bsgh', states, c_c)) + d_skip.astype(f32) * uf
    y = jax.nn.gelu(y).reshape(bsz, seq, S5_WIDTH)
    y = y * jax.nn.sigmoid(y @ w_glu.astype(f32) + b_glu.astype(f32))
    return y.astype(u.dtype)


def hybrid_mixer(h, w_in, conv_w, conv_b, b_i, b_f, mlstm_norm, lam_re, lam_im, log_dt,
                 b_re, b_im, c_re, c_im, d_skip, w_glu, b_glu, w_out):
    bsz, seq, _ = h.shape
    proj = h @ w_in
    idx = [QK_COLS, QK_COLS + V_COLS, QK_COLS + V_COLS + O_COLS,
           QK_COLS + V_COLS + O_COLS + GATE_COLS, QK_COLS + V_COLS + O_COLS + 2 * GATE_COLS]
    qk, v, o, ig, fg, u = jnp.split(proj, idx, axis=-1)

    qk = jax.nn.silu(causal_depthwise_conv(qk, conv_w, conv_b))
    q, k = jnp.split(qk, 2, axis=-1)
    f32 = jnp.float32
    q = q.reshape(bsz, seq, MLSTM_HEADS, MLSTM_QK_DIM).astype(f32)
    k = k.reshape(bsz, seq, MLSTM_HEADS, MLSTM_QK_DIM).astype(f32)
    vh = v.reshape(bsz, seq, MLSTM_HEADS, MLSTM_V_DIM).astype(f32)
    i_pre = ig.astype(f32) + b_i.astype(f32)
    f_pre = fg.astype(f32) + b_f.astype(f32)
    hm = mlstm_chunkwise(q, k, vh, i_pre, f_pre)
    hm = rms_norm(hm, mlstm_norm.reshape(MLSTM_HEADS, MLSTM_V_DIM))
    hm = (hm.reshape(bsz, seq, MLSTM_WIDTH) * jax.nn.sigmoid(o.astype(f32))).astype(h.dtype)

    hs = s5_branch(u, lam_re, lam_im, log_dt, b_re, b_im, c_re, c_im, d_skip, w_glu, b_glu)

    return jnp.concatenate([hm, hs], axis=-1) @ w_out


def setup_inputs(seed: int = 0) -> dict:
    key = jax.random.key(seed)
    ks = jax.random.split(key, 32)
    f32 = jnp.float32
    L = DEPTH

    def nrm(k, shape, scale):
        return jax.random.normal(k, shape, f32) * scale

    def gain(k, shape):
        return 1.0 + 0.02 * jax.random.normal(k, shape, f32)

    lam_im = math.pi * jnp.arange(S5_STATE, dtype=f32)[None, None, :] + nrm(ks[13], (L, S5_GROUPS, S5_STATE), 0.01)
    b_f = jnp.linspace(3.0, 6.0, MLSTM_HEADS, dtype=f32)[None, :] + nrm(ks[10], (L, MLSTM_HEADS), 0.1)
    return {
        "x": nrm(ks[0], (BATCH, SEQ, D_MODEL), 1.0),
        "ffn1_norm": gain(ks[1], (L, D_MODEL)),
        "ffn1_w1": nrm(ks[2], (L, D_MODEL, D_FF), D_MODEL ** -0.5),
        "ffn1_w3": nrm(ks[3], (L, D_MODEL, D_FF), D_MODEL ** -0.5),
        "ffn1_w2": nrm(ks[4], (L, D_FF, D_MODEL), D_FF ** -0.5),
        "mix_norm": gain(ks[5], (L, D_MODEL)),
        "w_in": nrm(ks[6], (L, D_MODEL, IN_COLS), D_MODEL ** -0.5),
        "conv_w": nrm(ks[7], (L, CONV_WIDTH, QK_COLS), CONV_WIDTH ** -0.5),
        "conv_b": nrm(ks[8], (L, QK_COLS), 0.01),
        "b_i": nrm(ks[9], (L, MLSTM_HEADS), 0.1),
        "b_f": b_f,
        "mlstm_norm": gain(ks[11], (L, MLSTM_WIDTH)),
        "lam_re": -0.5 + nrm(ks[12], (L, S5_GROUPS, S5_STATE), 0.01),
        "lam_im": lam_im,
        "log_dt": jax.random.uniform(ks[14], (L, S5_GROUPS), f32, math.log(DT_MIN), math.log(DT_MAX)),
        "b_re": nrm(ks[15], (L, S5_GROUPS, S5_STATE, S5_GROUP), (2 * S5_GROUP) ** -0.5),
        "b_im": nrm(ks[16], (L, S5_GROUPS, S5_STATE, S5_GROUP), (2 * S5_GROUP) ** -0.5),
        "c_re": nrm(ks[17], (L, S5_GROUPS, S5_GROUP, S5_STATE), (2 * S5_STATE) ** -0.5),
        "c_im": nrm(ks[18], (L, S5_GROUPS, S5_GROUP, S5_STATE), (2 * S5_STATE) ** -0.5),
        "d_skip": nrm(ks[19], (L, S5_GROUPS, S5_GROUP), 1.0),
        "w_glu": nrm(ks[20], (L, S5_WIDTH, S5_WIDTH), S5_WIDTH ** -0.5),
        "b_glu": nrm(ks[21], (L, S5_WIDTH), 0.01),
        "w_out": nrm(ks[22], (L, D_MIX, D_MODEL), D_MIX ** -0.5),
        "ffn2_norm": gain(ks[23], (L, D_MODEL)),
        "ffn2_w1": nrm(ks[24], (L, D_MODEL, D_FF), D_MODEL ** -0.5),
        "ffn2_w3": nrm(ks[25], (L, D_MODEL, D_FF), D_MODEL ** -0.5),
        "ffn2_w2": nrm(ks[26], (L, D_FF, D_MODEL), D_FF ** -0.5),
        "final_norm": gain(ks[27], (D_MODEL,)),
    }


def reference(x, ffn1_norm, ffn1_w1, ffn1_w3, ffn1_w2, mix_norm, w_in, conv_w, conv_b, b_i, b_f,
              mlstm_norm, lam_re, lam_im, log_dt, b_re, b_im, c_re, c_im, d_skip, w_glu, b_glu,
              w_out, ffn2_norm, ffn2_w1, ffn2_w3, ffn2_w2, final_norm):
    for l in range(DEPTH):
        x = x + 0.5 * swiglu(rms_norm(x, ffn1_norm[l]), ffn1_w1[l], ffn1_w3[l], ffn1_w2[l])
        h = rms_norm(x, mix_norm[l])
        x = x + hybrid_mixer(h, w_in[l], conv_w[l], conv_b[l], b_i[l], b_f[l], mlstm_norm[l],
                             lam_re[l], lam_im[l], log_dt[l], b_re[l], b_im[l], c_re[l], c_im[l],
                             d_skip[l], w_glu[l], b_glu[l], w_out[l])
        x = x + 0.5 * swiglu(rms_norm(x, ffn2_norm[l]), ffn2_w1[l], ffn2_w3[l], ffn2_w2[l])
    return rms_norm(x, final_norm)
```

```cpp
#include <hip/hip_runtime.h>
#include <hip/hip_cooperative_groups.h>
#include <cstdio>
namespace cg = cooperative_groups;

#define LAS __attribute__((address_space(3)))
typedef unsigned short bf16_t;
typedef short bf16x8 __attribute__((ext_vector_type(8)));
typedef float f32x4 __attribute__((ext_vector_type(4)));
typedef float f32x2 __attribute__((ext_vector_type(2)));
typedef unsigned u32x4 __attribute__((ext_vector_type(4)));
typedef unsigned u32x2 __attribute__((ext_vector_type(2)));

constexpr int T_TOK = 16384, DM = 2048, DFF = 5632, SEQ = 2048;
constexpr int INC = 4104;
constexpr float EPS = 1e-6f;
constexpr int LDS_BYTES = 131072;
constexpr size_t MiB = 1024 * 1024;
constexpr size_t WS_W13_1 = 0, WS_W2_1 = 44 * MiB, WS_W13_2 = 66 * MiB, WS_W2_2 = 110 * MiB, WS_WIN = 132 * MiB, WS_WOUT = 148 * MiB,
                 WS_WGLU = 156 * MiB, WS_BTC = 158 * MiB, WS_BTE = 170 * MiB, WS_WG = 174 * MiB, WS_SMALL = 175 * MiB,
                 WS_XB = 178 * MiB, WS_G = 242 * MiB, WS_MIX = 418 * MiB, WS_END = 482 * MiB;
constexpr size_t WS_QK = WS_G, WS_V = WS_G + 32 * MiB, WS_O = WS_G + 64 * MiB, WS_UX = WS_G + 96 * MiB, WS_E = WS_G + 144 * MiB, WS_YS = WS_QK;
constexpr size_t SM_SSQ0 = 0, SM_SSQ1 = 16384, SM_SSQ2 = 32768, SM_SSQ3 = 49152, SM_SSQH = 65536, SM_GATES = 131072, SM_LAML = 262144, SM_ENDF = 262144 + 8192;

struct Params { const float* in[28]; float* out; unsigned char* ws; };
enum { I_X = 0, I_F1N, I_F1W1, I_F1W3, I_F1W2, I_MIXN, I_WIN, I_CONVW, I_CONVB, I_BI, I_BF, I_MLN, I_LRE, I_LIM, I_LDT, I_BRE, I_BIM, I_CRE, I_CIM, I_DSK,
       I_WGLU, I_BGLU, I_WOUT, I_F2N, I_F2W1, I_F2W3, I_F2W2, I_FINN };

__device__ __forceinline__ unsigned cvt_pk_bf16(float lo, float hi) { unsigned r; asm volatile("v_cvt_pk_bf16_f32 %0, %1, %2" : "=v"(r) : "v"(lo), "v"(hi)); return r; }
__device__ __forceinline__ float bf_lo(unsigned u) { return __uint_as_float(u << 16); }
__device__ __forceinline__ float bf_hi(unsigned u) { return __uint_as_float(u & 0xffff0000u); }
__device__ __forceinline__ float bf2f(bf16_t b) { return __uint_as_float(((unsigned)b) << 16); }
__device__ __forceinline__ bf16_t f2bf(float f) { return (bf16_t)(cvt_pk_bf16(f, 0.f) & 0xffffu); }
__device__ __forceinline__ float sigmoidf_(float x) { return 1.0f / (1.0f + __expf(-x)); }
__device__ __forceinline__ float siluf_(float x) { return x / (1.0f + __expf(-x)); }
__device__ __forceinline__ float gelu_tanh(float x) { const float u = 0.7978845608f * (x + 0.044715f * x * x * x); return x / (1.0f + __expf(-2.0f * u)); }
__device__ __forceinline__ float rs_of(float ssq, float inv_n) { return rsqrtf(ssq * inv_n + EPS); }

namespace pg8 {
constexpr int BM = 256, BK = 64, HALF = 128, HTB = HALF * BK * 2, NXCD = 8, WGM = 8;
__host__ __device__ __forceinline__ int lds_byte(int r, int c) { const int st = (r >> 4) * 2 + (c >> 5), rr = r & 15, cc = c & 31, ob = rr * 64 + cc * 2; return st * 1024 + (ob ^ (((ob >> 9) & 1) << 5)); }
__host__ __device__ __forceinline__ void stage_rc(int b, int& R, int& C) { const int st = b / 1024, sb = b % 1024, swz = sb ^ (((sb >> 9) & 1) << 5); R = (st >> 1) * 16 + swz / 64; C = (st & 1) * 32 + (swz % 64) / 2; }
__host__ __device__ __forceinline__ int perm32(int rho) { const int n = rho >> 4, i = rho & 15; return 8 * (i >> 2) + 4 * n + (i & 3); }
struct Unit { int pm, pn; };
struct Gemm { const bf16_t* A; const bf16_t* Bt; int M, N, K, lda, ldb; };
struct StaticOrder {
    int nM, nN, nwg, G, c;
    __device__ void init(int M, int N, int G_, int c_) { nM = M / BM; nN = N / BM; nwg = nM * nN; G = G_; c = c_; }
    __device__ bool next(int i, Unit& u) const {
        const long L = (long)i * G + c; if (L >= nwg) return false;
        int wgid = (int)L; { const int q = nwg / NXCD, r = nwg % NXCD, xcd = wgid % NXCD, off = wgid / NXCD; wgid = (xcd < r ? xcd * (q + 1) : r * (q + 1) + (xcd - r) * q) + off; }
        const int nig = WGM * nN, gid = wgid / nig, fm = gid * WGM, gsz = (nM - fm) < WGM ? (nM - fm) : WGM;
        u.pm = fm + ((wgid % nig) % gsz); u.pn = (wgid % nig) / gsz; return true;
    }
};
template <class Epi>
__device__ __forceinline__ void gemm_phase(LAS unsigned char* lds, const Gemm g, const StaticOrder& S, const Epi& E) {
    const int tid = threadIdx.x, wid = __builtin_amdgcn_readfirstlane(tid >> 6), lane = tid & 63, wr = wid >> 2, wc = wid & 3, fr = lane & 15, fq = lane >> 4;
    const int K = g.K, nt = K / BK;
    unsigned voffA[2], voffB[2];
#pragma unroll
    for (int i = 0; i < 2; ++i) { int R, C; stage_rc(tid * 16 + i * 8192, R, C); const int Rb = (R & ~31) + perm32(R & 31);
        voffA[i] = (unsigned)(R * g.lda + C) * 2u; voffB[i] = (unsigned)(Rb * g.ldb + C) * 2u; }
    const size_t kstep = (size_t)(BK * 2);
    const size_t hstepA = (size_t)HALF * g.lda * 2, hstepB = (size_t)HALF * g.ldb * 2;
    const size_t tstepA = 2 * hstepA, tstepB = 2 * hstepB;
    const unsigned ldsw = (unsigned)wid * 1024u;
    const int aoff = lds_byte(wr * 64 + fr, fq * 8), boff = lds_byte(wc * 32 + fr, fq * 8);
#define PG8_SA(b, h) (((b) * 2 + (h)) * HTB)
#define PG8_SB(b, h) ((4 + (b) * 2 + (h)) * HTB)
#define PG8_STAGE(bufoff, gbase, voff) do { _Pragma("unroll") for (int _i = 0; _i < 2; ++_i) \
        __builtin_amdgcn_global_load_lds((const unsigned*)((const char*)(gbase) + (voff)[_i]), (LAS unsigned*)(lds + (bufoff) + ldsw + _i * 8192), 16, 0, 0); } while (0)
#define PG8_LDA(dst, b, h) do { _Pragma("unroll") for (int m = 0; m < 4; ++m) _Pragma("unroll") for (int k = 0; k < 2; ++k) dst[m][k] = *(const LAS bf16x8*)(lds + PG8_SA(b, h) + aoff + m * 2048 + k * 1024); } while (0)
#define PG8_LDB(dst, b, h) do { _Pragma("unroll") for (int n = 0; n < 2; ++n) _Pragma("unroll") for (int k = 0; k < 2; ++k) dst[n][k] = *(const LAS bf16x8*)(lds + PG8_SB(b, h) + boff + n * 2048 + k * 1024); } while (0)
#define PG8_MMA(ai, bj, At, Bt) do { __builtin_amdgcn_s_setprio(1); _Pragma("unroll") for (int m = 0; m < 4; ++m) _Pragma("unroll") for (int n = 0; n < 2; ++n) _Pragma("unroll") for (int k = 0; k < 2; ++k) \
        acc[ai][bj][m][n] = __builtin_amdgcn_mfma_f32_16x16x32_bf16(Bt[n][k], At[m][k], acc[ai][bj][m][n], 0, 0, 0); __builtin_amdgcn_s_setprio(0); } while (0)
#define PG8_WAIT_V(n) asm volatile("s_waitcnt vmcnt(" #n ")" ::: "memory")
#define PG8_WAIT_L(n) asm volatile("s_waitcnt lgkmcnt(" #n ")" ::: "memory")
#define PG8_BAR __builtin_amdgcn_s_barrier()
#define PG8_SCHED __builtin_amdgcn_sched_barrier(0)
    Unit cur, nxt; int ui = 0;
    if (!S.next(0, cur)) return;
    f32x4 acc[2][2][4][2];
#pragma unroll
    for (int a = 0; a < 2; ++a)
#pragma unroll
        for (int b = 0; b < 2; ++b)
#pragma unroll
            for (int m = 0; m < 4; ++m)
#pragma unroll
                for (int n = 0; n < 2; ++n) acc[a][b][m][n] = (f32x4){0.f, 0.f, 0.f, 0.f};
    bf16x8 At[4][2], B0[2][2], B1[2][2];
    const char* cA = (const char*)g.A + (size_t)cur.pm * tstepA; const char* cB = (const char*)g.Bt + (size_t)cur.pn * tstepB;
    PG8_STAGE(PG8_SB(0, 0), cB, voffB); PG8_STAGE(PG8_SA(0, 0), cA, voffA); PG8_STAGE(PG8_SB(0, 1), cB + hstepB, voffB); PG8_STAGE(PG8_SA(0, 1), cA + hstepA, voffA);
    if (wr == 1) PG8_BAR;
    PG8_WAIT_V(4); PG8_BAR;
    PG8_STAGE(PG8_SB(1, 0), cB + kstep, voffB); PG8_STAGE(PG8_SA(1, 0), cA + kstep, voffA); PG8_STAGE(PG8_SB(1, 1), cB + hstepB + kstep, voffB);
    PG8_WAIT_V(6); PG8_BAR;
    for (;;) {
        const bool has_next = S.next(ui + 1, nxt);
        const char* nA = has_next ? (const char*)g.A + (size_t)nxt.pm * tstepA : cA; const char* nB = has_next ? (const char*)g.Bt + (size_t)nxt.pn * tstepB : cB;
        for (int t = 0; t < nt; t += 2) {
            const bool last = (t == nt - 2);
            const char* a1 = cA + (size_t)(t + 1) * kstep;
            const char* a2 = last ? nA : cA + (size_t)(t + 2) * kstep; const char* b2 = last ? nB : cB + (size_t)(t + 2) * kstep;
            const char* a3 = a2 + kstep; const char* b3 = b2 + kstep;
            PG8_LDB(B0, 0, 0); PG8_SCHED; PG8_LDA(At, 0, 0); PG8_STAGE(PG8_SA(1, 1), a1 + hstepA, voffA);
            PG8_WAIT_L(8); PG8_BAR; PG8_WAIT_L(0); PG8_MMA(0, 0, At, B0); PG8_BAR; PG8_SCHED;
            PG8_LDB(B1, 0, 1); PG8_STAGE(PG8_SB(0, 0), b2, voffB);
            PG8_BAR; PG8_WAIT_L(0); PG8_MMA(0, 1, At, B1); PG8_BAR;
            PG8_LDA(At, 0, 1); PG8_STAGE(PG8_SA(0, 0), a2, voffA);
            PG8_BAR; PG8_WAIT_L(0); PG8_MMA(1, 0, At, B0); PG8_BAR; PG8_SCHED;
            PG8_STAGE(PG8_SB(0, 1), b2 + hstepB, voffB);
            PG8_WAIT_V(6); PG8_BAR; PG8_MMA(1, 1, At, B1); PG8_BAR;
            PG8_LDB(B0, 1, 0); PG8_SCHED; PG8_LDA(At, 1, 0); PG8_STAGE(PG8_SA(0, 1), a2 + hstepA, voffA);
            PG8_WAIT_L(8); PG8_BAR; PG8_WAIT_L(0); PG8_MMA(0, 0, At, B0); PG8_BAR; PG8_SCHED;
            PG8_LDB(B1, 1, 1); PG8_STAGE(PG8_SB(1, 0), b3, voffB);
            PG8_BAR; PG8_WAIT_L(0); PG8_MMA(0, 1, At, B1); PG8_BAR;
            PG8_LDA(At, 1, 1); PG8_STAGE(PG8_SA(1, 0), a3, voffA);
            PG8_BAR; PG8_WAIT_L(0); PG8_MMA(1, 0, At, B0); PG8_BAR; PG8_SCHED;
            PG8_STAGE(PG8_SB(1, 1), b3 + hstepB, voffB);
            PG8_WAIT_V(6); PG8_BAR; PG8_MMA(1, 1, At, B1); PG8_BAR;
        }
        E(acc, cur, wr, wc, fr, fq);
        if (!has_next) break;
#pragma unroll
        for (int a = 0; a < 2; ++a)
#pragma unroll
            for (int b = 0; b < 2; ++b)
#pragma unroll
                for (int m = 0; m < 4; ++m)
#pragma unroll
                    for (int n = 0; n < 2; ++n) acc[a][b][m][n] = (f32x4){0.f, 0.f, 0.f, 0.f};
        cur = nxt; cA = nA; cB = nB; ++ui;
    }
    PG8_WAIT_V(0);
    if (wr == 0) PG8_BAR;
    PG8_BAR;
#undef PG8_SA
#undef PG8_SB
#undef PG8_STAGE
#undef PG8_LDA
#undef PG8_LDB
#undef PG8_MMA
#undef PG8_WAIT_V
#undef PG8_WAIT_L
#undef PG8_BAR
#undef PG8_SCHED
}
}
using pg8::Unit;
typedef const f32x4 (&AccRef)[2][2][4][2];

struct EpiSwiGLU {
    bf16_t* G; const float* ssq;
    __device__ __forceinline__ void operator()(AccRef acc, const Unit& u, int wr, int wc, int fr, int fq) const {
        const int row0 = u.pm * 256 + wr * 64 + fr, col0 = u.pn * 128 + wc * 32 + 8 * fq;
#pragma unroll
        for (int ai = 0; ai < 2; ++ai)
#pragma unroll
            for (int m = 0; m < 4; ++m) {
                const int r = row0 + ai * 128 + m * 16; const float rs = rs_of(ssq[r], 1.0f / DM);
                float o[8];
#pragma unroll
                for (int n = 0; n < 2; ++n)
#pragma unroll
                    for (int j = 0; j < 4; ++j) { const float a1 = rs * acc[ai][0][m][n][j], a3 = rs * acc[ai][1][m][n][j]; o[n * 4 + j] = siluf_(a1) * a3; }
                u32x4 w; w.x = cvt_pk_bf16(o[0], o[1]); w.y = cvt_pk_bf16(o[2], o[3]); w.z = cvt_pk_bf16(o[4], o[5]); w.w = cvt_pk_bf16(o[6], o[7]);
                *(u32x4*)(G + (size_t)r * DFF + col0) = w;
            }
    }
};
struct EpiResid {
    const float* base; float* out; bf16_t* xb; float* ssq; float scale;
    __device__ __forceinline__ void operator()(AccRef acc, const Unit& u, int wr, int wc, int fr, int fq) const {
        const int row0 = u.pm * 256 + wr * 64 + fr, col0 = u.pn * 256 + wc * 32 + 8 * fq;
#pragma unroll
        for (int ai = 0; ai < 2; ++ai)
#pragma unroll
            for (int m = 0; m < 4; ++m) {
                const int r = row0 + ai * 128 + m * 16; float s = 0.f;
#pragma unroll
                for (int bj = 0; bj < 2; ++bj) {
                    const size_t off = (size_t)r * DM + col0 + bj * 128;
                    const f32x4 b0 = *(const f32x4*)(base + off), b1 = *(const f32x4*)(base + off + 4);
                    const f32x4 v0 = b0 + scale * acc[ai][bj][m][0], v1 = b1 + scale * acc[ai][bj][m][1];
                    *(f32x4*)(out + off) = v0; *(f32x4*)(out + off + 4) = v1;
                    s += v0[0] * v0[0] + v0[1] * v0[1] + v0[2] * v0[2] + v0[3] * v0[3] + v1[0] * v1[0] + v1[1] * v1[1] + v1[2] * v1[2] + v1[3] * v1[3];
                    if (xb) { u32x4 w; w.x = cvt_pk_bf16(v0[0], v0[1]); w.y = cvt_pk_bf16(v0[2], v0[3]); w.z = cvt_pk_bf16(v1[0], v1[1]); w.w = cvt_pk_bf16(v1[2], v1[3]); *(u32x4*)(xb + off) = w; }
                }
                s += __shfl_xor(s, 16); s += __shfl_xor(s, 32);
                if (fq == 0) atomicAdd(ssq + r, s);
            }
    }
};
struct EpiWin {
    bf16_t* QK; bf16_t* V; bf16_t* O; bf16_t* UX; const float* ssq;
    __device__ __forceinline__ void operator()(AccRef acc, const Unit& u, int wr, int wc, int fr, int fq) const {
        const int row0 = u.pm * 256 + wr * 64 + fr, region = u.pn >> 2, colr0 = (u.pn & 3) * 256 + wc * 32 + 8 * fq;
#pragma unroll
        for (int ai = 0; ai < 2; ++ai)
#pragma unroll
            for (int m = 0; m < 4; ++m) {
                const int r = row0 + ai * 128 + m * 16; const float rs = rs_of(ssq[r], 1.0f / DM);
#pragma unroll
                for (int bj = 0; bj < 2; ++bj) {
                    const int colr = colr0 + bj * 128;
                    f32x4 v0 = rs * acc[ai][bj][m][0], v1 = rs * acc[ai][bj][m][1];
                    if (region == 2) {
#pragma unroll
                        for (int j = 0; j < 4; ++j) { v0[j] = sigmoidf_(v0[j]); v1[j] = sigmoidf_(v1[j]); } }
                    u32x4 w; w.x = cvt_pk_bf16(v0[0], v0[1]); w.y = cvt_pk_bf16(v0[2], v0[3]); w.z = cvt_pk_bf16(v1[0], v1[1]); w.w = cvt_pk_bf16(v1[2], v1[3]);
                    bf16_t* dst;
                    if (region == 0) dst = QK + (size_t)r * 1024 + colr;
                    else if (region == 1) dst = V + (size_t)r * 1024 + colr;
                    else if (region == 2) dst = O + (size_t)r * 1024 + colr;
                    else dst = UX + ((size_t)(colr >> 4) * 1024 + (r >> 4)) * 384 + (r & 15) * 16 + (colr & 15);
                    *(u32x4*)dst = w;
                }
            }
    }
};
struct EpiGLU {
    const bf16_t* YS; bf16_t* MIX; const float* bias;
    __device__ __forceinline__ void operator()(AccRef acc, const Unit& u, int wr, int wc, int fr, int fq) const {
        const int row0 = u.pm * 256 + wr * 64 + fr, col0 = u.pn * 256 + wc * 32 + 8 * fq;
#pragma unroll
        for (int ai = 0; ai < 2; ++ai)
#pragma unroll
            for (int m = 0; m < 4; ++m) {
                const int r = row0 + ai * 128 + m * 16;
#pragma unroll
                for (int bj = 0; bj < 2; ++bj) {
                    const int c = col0 + bj * 128;
                    const u32x4 y = *(const u32x4*)(YS + (size_t)r * 1024 + c);
                    const f32x4 b0 = *(const f32x4*)(bias + c), b1 = *(const f32x4*)(bias + c + 4);
                    const f32x4 a0 = acc[ai][bj][m][0] + b0, a1 = acc[ai][bj][m][1] + b1;
                    u32x4 w;
                    w.x = cvt_pk_bf16(bf_lo(y.x) * sigmoidf_(a0[0]), bf_hi(y.x) * sigmoidf_(a0[1]));
                    w.y = cvt_pk_bf16(bf_lo(y.y) * sigmoidf_(a0[2]), bf_hi(y.y) * sigmoidf_(a0[3]));
                    w.z = cvt_pk_bf16(bf_lo(y.z) * sigmoidf_(a1[0]), bf_hi(y.z) * sigmoidf_(a1[1]));
                    w.w = cvt_pk_bf16(bf_lo(y.w) * sigmoidf_(a1[2]), bf_hi(y.w) * sigmoidf_(a1[3]));
                    *(u32x4*)(MIX + (size_t)r * 2048 + 1024 + c) = w;
                }
            }
    }
};

template <class Epi>
__device__ __forceinline__ void sgemm_unit(LAS unsigned char* lds, const bf16_t* A, int lda, const bf16_t* Bt, int ldb, int K, const Epi& E) {
    const int tid = threadIdx.x, w = tid >> 6, lane = tid & 63, fr = lane & 15, fq = lane >> 4, wr = w >> 2, wc = w & 3;
    LAS bf16_t* As = (LAS bf16_t*)lds; LAS bf16_t* Bs = (LAS bf16_t*)(lds + 18432);
    f32x4 acc[4][2];
#pragma unroll
    for (int m = 0; m < 4; ++m)
#pragma unroll
        for (int n = 0; n < 2; ++n) acc[m][n] = (f32x4){0.f, 0.f, 0.f, 0.f};
    u32x4 ra[2], rb[2];
    const int lr0 = tid >> 3, lc = (tid & 7) * 8;
#pragma unroll
    for (int i = 0; i < 2; ++i) { ra[i] = *(const u32x4*)(A + (size_t)(lr0 + 64 * i) * lda + lc); rb[i] = *(const u32x4*)(Bt + (size_t)(lr0 + 64 * i) * ldb + lc); }
    for (int k0 = 0; k0 < K; k0 += 64) {
        __syncthreads();
#pragma unroll
        for (int i = 0; i < 2; ++i) { *(LAS u32x4*)(As + (lr0 + 64 * i) * 72 + lc) = ra[i]; *(LAS u32x4*)(Bs + (lr0 + 64 * i) * 72 + lc) = rb[i]; }
        __syncthreads();
        if (k0 + 64 < K) {
#pragma unroll
            for (int i = 0; i < 2; ++i) { ra[i] = *(const u32x4*)(A + (size_t)(lr0 + 64 * i) * lda + k0 + 64 + lc); rb[i] = *(const u32x4*)(Bt + (size_t)(lr0 + 64 * i) * ldb + k0 + 64 + lc); }
        }
#pragma unroll
        for (int kk = 0; kk < 2; ++kk) {
            bf16x8 af[4], bfv[2];
#pragma unroll
            for (int m = 0; m < 4; ++m) af[m] = *(const LAS bf16x8*)(As + (wr * 64 + m * 16 + fr) * 72 + kk * 32 + fq * 8);
#pragma unroll
            for (int n = 0; n < 2; ++n) bfv[n] = *(const LAS bf16x8*)(Bs + (wc * 32 + n * 16 + fr) * 72 + kk * 32 + fq * 8);
#pragma unroll
            for (int m = 0; m < 4; ++m)
#pragma unroll
                for (int n = 0; n < 2; ++n) acc[m][n] = __builtin_amdgcn_mfma_f32_16x16x32_bf16(bfv[n], af[m], acc[m][n], 0, 0, 0);
        }
    }
#pragma unroll
    for (int m = 0; m < 4; ++m)
#pragma unroll
        for (int n = 0; n < 2; ++n) E(wr * 64 + m * 16 + fr, wc * 32 + n * 16 + 4 * fq, acc[m][n]);
    __syncthreads();
}

__device__ __forceinline__ void cvt_tile(const float* src, int ldsrc, int col0, int k0, const float* gain, bf16_t* dst, int lddst, int nrow0, LAS float* tile) {
    const int tid = threadIdx.x, r = tid >> 4, c4 = (tid & 15) * 4;
    f32x4 v[8];
#pragma unroll
    for (int i = 0; i < 8; ++i) v[i] = *(const f32x4*)(src + (size_t)(k0 + r + 32 * i) * ldsrc + col0 + c4);
#pragma unroll
    for (int i = 0; i < 8; ++i) { const float g = gain ? gain[k0 + r + 32 * i] : 1.0f; LAS float* t = tile + (r + 32 * i) * 65 + c4; t[0] = v[i][0] * g; t[1] = v[i][1] * g; t[2] = v[i][2] * g; t[3] = v[i][3] * g; }
    __syncthreads();
    const int n = tid >> 3, k8 = tid & 7;
#pragma unroll
    for (int i = 0; i < 4; ++i) {
        const int kk = (k8 + 8 * i) * 8; const LAS float* t = tile + kk * 65 + n;
        u32x4 w; w.x = cvt_pk_bf16(t[0], t[65]); w.y = cvt_pk_bf16(t[130], t[195]); w.z = cvt_pk_bf16(t[260], t[325]); w.w = cvt_pk_bf16(t[390], t[455]);
        *(u32x4*)(dst + (size_t)(nrow0 + n) * lddst + k0 + kk) = w;
    }
    __syncthreads();
}

__device__ void s5_prep_group(const Params& P, LAS unsigned char* lds, int g) {
    const int tid = threadIdx.x;
    LAS float* Pw = (LAS float*)lds;
    LAS float* Bb = Pw + 17 * 128;
    LAS float* Cc = Bb + 2048;
    LAS float* Kt = Cc + 2048;
    const float dt = __expf(P.in[I_LDT][g]);
    if (tid < 64) {
        const int p = tid; const float lr = P.in[I_LRE][g * 64 + p], li = P.in[I_LIM][g * 64 + p];
        for (int tau = 0; tau <= 16; ++tau) { const float e = __expf(lr * dt * tau); float sn, cs; sincosf(li * dt * tau, &sn, &cs); Pw[(tau * 64 + p) * 2] = e * cs; Pw[(tau * 64 + p) * 2 + 1] = e * sn; }
        float* laml = (float*)(P.ws + WS_SMALL) + SM_LAML;
        laml[(g * 64 + p) * 2] = Pw[(16 * 64 + p) * 2]; laml[(g * 64 + p) * 2 + 1] = Pw[(16 * 64 + p) * 2 + 1];
    }
    for (int i = tid; i < 1024; i += 512) {
        const int p = i >> 4; const float lr = P.in[I_LRE][g * 64 + p], li = P.in[I_LIM][g * 64 + p];
        const float e = __expf(lr * dt); float sn, cs; sincosf(li * dt, &sn, &cs);
        const float nr = e * cs - 1.0f, ni = e * sn, den = 1.0f / (lr * lr + li * li);
        const float fr_ = (nr * lr + ni * li) * den, fi_ = (ni * lr - nr * li) * den;
        const float br = P.in[I_BRE][(size_t)g * 1024 + i], bi = P.in[I_BIM][(size_t)g * 1024 + i];
        Bb[i * 2] = fr_ * br - fi_ * bi; Bb[i * 2 + 1] = fr_ * bi + fi_ * br;
        Cc[i * 2] = P.in[I_CRE][(size_t)g * 1024 + i]; Cc[i * 2 + 1] = P.in[I_CIM][(size_t)g * 1024 + i];
    }
    __syncthreads();
    for (int i = tid; i < 4096; i += 512) {
        const int tau = i >> 8, h = (i >> 4) & 15, hp = i & 15; float s = 0.f;
        for (int p = 0; p < 64; ++p) {
            const float cr = Cc[(h * 64 + p) * 2], ci = Cc[(h * 64 + p) * 2 + 1], pr = Pw[(tau * 64 + p) * 2], pi = Pw[(tau * 64 + p) * 2 + 1];
            const float zr = cr * pr - ci * pi, zi = cr * pi + ci * pr;
            s += zr * Bb[(p * 16 + hp) * 2] - zi * Bb[(p * 16 + hp) * 2 + 1];
        }
        if (tau == 0 && h == hp) s += P.in[I_DSK][g * 16 + h];
        Kt[i] = s;
    }
    __syncthreads();
    bf16_t* btc = (bf16_t*)(P.ws + WS_BTC) + (size_t)g * 256 * 384;
    for (int i = tid; i < 256 * 48; i += 512) {
        const int n = i / 48, k0 = (i % 48) * 8, t = n >> 4, h = n & 15; float o[8];
#pragma unroll
        for (int e = 0; e < 8; ++e) {
            const int k = k0 + e;
            if (k < 256) { const int s = k >> 4, hp = k & 15; o[e] = (t >= s) ? Kt[((t - s) * 16 + h) * 16 + hp] : 0.f; }
            else { const int kk = k - 256, ri = kk >> 6, p = kk & 63; const float cr = Cc[(h * 64 + p) * 2], ci = Cc[(h * 64 + p) * 2 + 1], pr = Pw[((t + 1) * 64 + p) * 2], pi = Pw[((t + 1) * 64 + p) * 2 + 1];
                o[e] = ri == 0 ? (cr * pr - ci * pi) : -(cr * pi + ci * pr); }
        }
        u32x4 w; w.x = cvt_pk_bf16(o[0], o[1]); w.y = cvt_pk_bf16(o[2], o[3]); w.z = cvt_pk_bf16(o[4], o[5]); w.w = cvt_pk_bf16(o[6], o[7]);
        *(u32x4*)(btc + (size_t)n * 384 + k0) = w;
    }
    bf16_t* bte = (bf16_t*)(P.ws + WS_BTE) + (size_t)g * 128 * 256;
    for (int i = tid; i < 128 * 32; i += 512) {
        const int n = i >> 5, k0 = (i & 31) * 8, ri = n >> 6, p = n & 63; float o[8];
#pragma unroll
        for (int e = 0; e < 8; ++e) {
            const int k = k0 + e, s = k >> 4, hp = k & 15;
            const float pr = Pw[((15 - s) * 64 + p) * 2], pi = Pw[((15 - s) * 64 + p) * 2 + 1], br = Bb[(p * 16 + hp) * 2], bi = Bb[(p * 16 + hp) * 2 + 1];
            o[e] = ri == 0 ? (pr * br - pi * bi) : (pr * bi + pi * br);
        }
        u32x4 w; w.x = cvt_pk_bf16(o[0], o[1]); w.y = cvt_pk_bf16(o[2], o[3]); w.z = cvt_pk_bf16(o[4], o[5]); w.w = cvt_pk_bf16(o[6], o[7]);
        *(u32x4*)(bte + (size_t)n * 256 + k0) = w;
    }
    __syncthreads();
}

__device__ void phase_prep(const Params& P, LAS unsigned char* lds) {
    const int tid = threadIdx.x, bid = blockIdx.x, nb = gridDim.x;
    float* sm = (float*)(P.ws + WS_SMALL);
    for (int i = bid * 512 + tid; i < 49152 + 65536; i += nb * 512) sm[SM_SSQ1 + i] = 0.f;
    { bf16_t* wg = (bf16_t*)(P.ws + WS_WG);
      for (int i = bid * 512 + tid; i < 16 * 2048; i += nb * 512) { const int n = i >> 11, k = i & 2047; wg[i] = n < 8 ? f2bf(P.in[I_WIN][(size_t)k * INC + 3072 + n] * P.in[I_MIXN][k]) : (bf16_t)0; } }
    { const int w = tid >> 6, lane = tid & 63; bf16_t* xb = (bf16_t*)(P.ws + WS_XB);
      for (int row = bid * 8 + w; row < T_TOK; row += nb * 8) {
          const float* xr = P.in[I_X] + (size_t)row * DM; float s = 0.f;
#pragma unroll
          for (int it = 0; it < 8; ++it) { const f32x4 v = *(const f32x4*)(xr + (it * 64 + lane) * 4); s += v[0] * v[0] + v[1] * v[1] + v[2] * v[2] + v[3] * v[3];
              u32x2 o; o.x = cvt_pk_bf16(v[0], v[1]); o.y = cvt_pk_bf16(v[2], v[3]); *(u32x2*)(xb + (size_t)row * DM + (it * 64 + lane) * 4) = o; }
#pragma unroll
          for (int o = 32; o >= 1; o >>= 1) s += __shfl_xor(s, o);
          if (lane == 0) sm[SM_SSQ0 + row] = s;
      } }
    for (int g = bid; g < 64; g += nb) s5_prep_group(P, lds, g);
    LAS float* tile = (LAS float*)lds;
    constexpr int T_W13 = 176 * 8, T_W2 = 32 * 22, T_WIN = 64 * 8, T_WOUT = 32 * 8, T_WGLU = 16 * 4;
    constexpr int TOT = 2 * T_W13 + 2 * T_W2 + T_WIN + T_WOUT + T_WGLU;
    for (int t = bid; t < TOT; t += nb) {
        int i = t;
        if (i < 2 * T_W13) { const int f = i / T_W13; i -= f * T_W13; const int nt = i >> 3, kt = i & 7; const int np = nt * 64, pn = np >> 8, bj = (np >> 7) & 1, ii = np & 127;
            cvt_tile(P.in[f ? (bj ? I_F2W3 : I_F2W1) : (bj ? I_F1W3 : I_F1W1)], DFF, pn * 128 + ii, kt * 256, P.in[f ? I_F2N : I_F1N], (bf16_t*)(P.ws + (f ? WS_W13_2 : WS_W13_1)), DM, np, tile); continue; }
        i -= 2 * T_W13;
        if (i < 2 * T_W2) { const int f = i / T_W2; i -= f * T_W2; const int nt = i / 22, kt = i % 22;
            cvt_tile(P.in[f ? I_F2W2 : I_F1W2], DM, nt * 64, kt * 256, nullptr, (bf16_t*)(P.ws + (f ? WS_W2_2 : WS_W2_1)), DFF, nt * 64, tile); continue; }
        i -= 2 * T_W2;
        if (i < T_WIN) { const int nt = i >> 3, kt = i & 7, np = nt * 64;
            cvt_tile(P.in[I_WIN], INC, np < 3072 ? np : np + 8, kt * 256, P.in[I_MIXN], (bf16_t*)(P.ws + WS_WIN), DM, np, tile); continue; }
        i -= T_WIN;
        if (i < T_WOUT) { const int nt = i >> 3, kt = i & 7;
            cvt_tile(P.in[I_WOUT], DM, nt * 64, kt * 256, nullptr, (bf16_t*)(P.ws + WS_WOUT), DM, nt * 64, tile); continue; }
        i -= T_WOUT;
        { const int nt = i >> 2, kt = i & 3;
            cvt_tile(P.in[I_WGLU], 1024, nt * 64, kt * 256, nullptr, (bf16_t*)(P.ws + WS_WGLU), 1024, nt * 64, tile); }
    }
}

__device__ void phase_gates(const Params& P) {
    const int tid = threadIdx.x, w = tid >> 6, lane = tid & 63, fr = lane & 15, fq = lane >> 4;
    const bf16_t* xb = (const bf16_t*)(P.ws + WS_XB); const bf16_t* wg = (const bf16_t*)(P.ws + WS_WG);
    float* sm = (float*)(P.ws + WS_SMALL);
    for (int task = blockIdx.x * 8 + w; task < T_TOK / 16; task += gridDim.x * 8) {
        const int tok0 = task * 16; f32x4 acc = {0.f, 0.f, 0.f, 0.f};
        const bf16_t* ap = xb + (size_t)(tok0 + fr) * DM + fq * 8; const bf16_t* bp = wg + (size_t)fr * DM + fq * 8;
#pragma unroll 8
        for (int kk = 0; kk < 64; ++kk) { const bf16x8 a = *(const bf16x8*)(ap + kk * 32), b = *(const bf16x8*)(bp + kk * 32); acc = __builtin_amdgcn_mfma_f32_16x16x32_bf16(a, b, acc, 0, 0, 0); }
        if (fr < 8) {
            const float bias = fr < 4 ? P.in[I_BI][fr] : P.in[I_BF][fr - 4];
#pragma unroll
            for (int j = 0; j < 4; ++j) { const int tok = tok0 + fq * 4 + j; float v = rs_of(sm[SM_SSQ1 + tok], 1.0f / DM) * acc[j] + bias;
                if (fr >= 4) v = fminf(v, 0.f) - log1pf(__expf(-fabsf(v)));
                sm[SM_GATES + (size_t)tok * 8 + fr] = v; }
        }
    }
}

__device__ void phase_s5_scan(const Params& P) {
    const int tid = threadIdx.x; if (tid >= 128) return;
    const int idx = blockIdx.x * 128 + tid; if (idx >= 8 * 64 * 64) return;
    const float* E = (const float*)(P.ws + WS_E); bf16_t* UX = (bf16_t*)(P.ws + WS_UX); const float* laml = (const float*)(P.ws + WS_SMALL) + SM_LAML;
    for (int id = idx; id < 8 * 64 * 64; id += gridDim.x * 128) {
        const int p = id & 63, g = (id >> 6) & 63, b = id >> 12;
        const float lr = laml[(g * 64 + p) * 2], li = laml[(g * 64 + p) * 2 + 1]; float xr = 0.f, xi = 0.f;
        const size_t row0 = (size_t)g * 1024 + b * 128;
#pragma unroll 16
        for (int c = 0; c < 128; ++c) {
            const float er = E[(row0 + c) * 128 + p], ei = E[(row0 + c) * 128 + 64 + p];
            UX[(row0 + c) * 384 + 256 + p] = f2bf(xr); UX[(row0 + c) * 384 + 320 + p] = f2bf(xi);
            const float nr = lr * xr - li * xi + er, ni = lr * xi + li * xr + ei; xr = nr; xi = ni;
        }
    }
}

__device__ void mlstm_item(const Params& P, LAS unsigned char* lds, int item) {
    const int tid = threadIdx.x, w = __builtin_amdgcn_readfirstlane(tid >> 6), lane = tid & 63, fr = lane & 15, fq = lane >> 4;
    const int b = item >> 5, h = (item >> 3) & 3, js = item & 7;
    LAS bf16_t* qs = (LAS bf16_t*)(lds);
    LAS bf16_t* ks = (LAS bf16_t*)(lds + 17408);
    LAS bf16_t* kT = (LAS bf16_t*)(lds + 34816);
    LAS bf16_t* vT = (LAS bf16_t*)(lds + 53248);
    LAS bf16_t* vTd = (LAS bf16_t*)(lds + 60160);
    LAS bf16_t* Sp = (LAS bf16_t*)(lds + 67072);
    LAS bf16_t* Cb = (LAS bf16_t*)(lds + 76288);
    LAS float* fw = (LAS float*)(lds + 89344);
    LAS float* fM = fw + 64; LAS float* fa = fw + 128; LAS float* fen = fw + 192; LAS float* fd63 = fw + 256;
    const bf16_t* QK = (const bf16_t*)(P.ws + WS_QK); const bf16_t* V = (const bf16_t*)(P.ws + WS_V); bf16_t* MIX = (bf16_t*)(P.ws + WS_MIX);
    const float* gates = (const float*)(P.ws + WS_SMALL) + SM_GATES; float* ssqh = (float*)(P.ws + WS_SMALL) + SM_SSQH;
    __syncthreads();
    for (int i = tid; i < 64 * 72; i += 512) Sp[i] = 0;
    for (int i = tid; i < 16 * 72; i += 512) { const bf16_t v = (i < 72) ? (bf16_t)0x3F80 : (bf16_t)0; vT[32 * 72 + i] = v; vTd[32 * 72 + i] = 0; }
    const int dg = tid & 31, isK = dg >> 4, d0 = (dg & 15) * 8, convcol = (isK ? 512 : 0) + h * 128 + d0, tl = tid >> 5;
    float cw[4][8], cb[8];
#pragma unroll
    for (int j = 0; j < 4; ++j)
#pragma unroll
        for (int e = 0; e < 8; ++e) cw[j][e] = P.in[I_CONVW][j * 1024 + convcol + e];
#pragma unroll
    for (int e = 0; e < 8; ++e) cb[e] = P.in[I_CONVB][convcol + e];
    const float qscale = isK ? 1.0f : 0.08838834764831845f;
    f32x4 Cacc[3][2];
#pragma unroll
    for (int a = 0; a < 3; ++a)
#pragma unroll
        for (int c2 = 0; c2 < 2; ++c2) Cacc[a][c2] = (f32x4){0.f, 0.f, 0.f, 0.f};
    float m_prev = 0.f;
    for (int c = 0; c < 32; ++c) {
        const int t0 = c * 64; const size_t tokbase = (size_t)b * SEQ + t0;
        {
            u32x4 raw[7];
#pragma unroll
            for (int i = 0; i < 7; ++i) { const int pos = t0 + tl * 4 - 3 + i; raw[i] = pos >= 0 ? *(const u32x4*)(QK + ((size_t)b * SEQ + pos) * 1024 + convcol) : (u32x4){0u, 0u, 0u, 0u}; }
            float o[4][8];
#pragma unroll
            for (int tt = 0; tt < 4; ++tt) {
#pragma unroll
                for (int e = 0; e < 8; ++e) o[tt][e] = cb[e];
#pragma unroll
                for (int j = 0; j < 4; ++j) { const u32x4 x = raw[tt + j];
                    o[tt][0] += cw[j][0] * bf_lo(x.x); o[tt][1] += cw[j][1] * bf_hi(x.x); o[tt][2] += cw[j][2] * bf_lo(x.y); o[tt][3] += cw[j][3] * bf_hi(x.y);
                    o[tt][4] += cw[j][4] * bf_lo(x.z); o[tt][5] += cw[j][5] * bf_hi(x.z); o[tt][6] += cw[j][6] * bf_lo(x.w); o[tt][7] += cw[j][7] * bf_hi(x.w); }
#pragma unroll
                for (int e = 0; e < 8; ++e) o[tt][e] = siluf_(o[tt][e]) * qscale;
                u32x4 wv; wv.x = cvt_pk_bf16(o[tt][0], o[tt][1]); wv.y = cvt_pk_bf16(o[tt][2], o[tt][3]); wv.z = cvt_pk_bf16(o[tt][4], o[tt][5]); wv.w = cvt_pk_bf16(o[tt][6], o[tt][7]);
                *(LAS u32x4*)((isK ? ks : qs) + (tl * 4 + tt) * 136 + d0) = wv;
            }
            if (isK) {
#pragma unroll
                for (int e = 0; e < 8; ++e) { u32x2 wv; wv.x = cvt_pk_bf16(o[0][e], o[1][e]); wv.y = cvt_pk_bf16(o[2][e], o[3][e]); *(LAS u32x2*)(kT + (d0 + e) * 72 + tl * 4) = wv; }
            }
        }
        if (w == 0) {
            const float li = gates[(tokbase + lane) * 8 + h]; float x = gates[(tokbase + lane) * 8 + 4 + h];
#pragma unroll
            for (int off = 1; off < 64; off <<= 1) { const float t = __shfl_up(x, off); if (lane >= off) x += t; }
            const float wv = li - x; float pm = wv;
#pragma unroll
            for (int off = 1; off < 64; off <<= 1) { const float t = __shfl_up(pm, off); if (lane >= off) pm = fmaxf(pm, t); }
            const float Mv = fmaxf(m_prev, pm), av = __expf(m_prev - Mv), env = __expf(-(x + Mv));
            const float M63 = __shfl(Mv, 63), b63 = __shfl(x, 63);
            fw[lane] = wv; fM[lane] = Mv; fa[lane] = av; fen[lane] = env; fd63[lane] = __expf(wv - M63);
            m_prev = b63 + M63;
        }
        u32x4 vraw = {0u, 0u, 0u, 0u}; const int vs = (tid - 256) >> 2, vcg = (tid - 256) & 3;
        if (w >= 4) {
            vraw = *(const u32x4*)(V + (tokbase + vs) * 1024 + h * 256 + js * 32 + vcg * 8);
            LAS bf16_t* d = vT + (vcg * 8) * 72 + vs;
            d[0] = (bf16_t)(vraw.x & 0xffff); d[72] = (bf16_t)(vraw.x >> 16); d[144] = (bf16_t)(vraw.y & 0xffff); d[216] = (bf16_t)(vraw.y >> 16);
            d[288] = (bf16_t)(vraw.z & 0xffff); d[360] = (bf16_t)(vraw.z >> 16); d[432] = (bf16_t)(vraw.w & 0xffff); d[504] = (bf16_t)(vraw.w >> 16);
#pragma unroll
            for (int vt = 0; vt < 3; ++vt)
#pragma unroll
                for (int k2 = 0; k2 < 2; ++k2)
#pragma unroll
                    for (int j = 0; j < 4; ++j) Cb[(vt * 16 + fq * 4 + j) * 136 + ((w - 4) * 2 + k2) * 16 + fr] = f2bf(Cacc[vt][k2][j]);
        }
        __syncthreads();
        if (w >= 4) {
            const float d = fd63[vs]; LAS bf16_t* dd = vTd + (vcg * 8) * 72 + vs;
            dd[0] = f2bf(bf_lo(vraw.x) * d); dd[72] = f2bf(bf_hi(vraw.x) * d); dd[144] = f2bf(bf_lo(vraw.y) * d); dd[216] = f2bf(bf_hi(vraw.y) * d);
            dd[288] = f2bf(bf_lo(vraw.z) * d); dd[360] = f2bf(bf_hi(vraw.z) * d); dd[432] = f2bf(bf_lo(vraw.w) * d); dd[504] = f2bf(bf_hi(vraw.w) * d);
            if (vcg == 0) vTd[32 * 72 + vs] = f2bf(d);
        }
        for (int idx = w; idx < 10; idx += 8) {
            const int ti = (0xFFA94 >> (2 * idx)) & 3, si = (0xE4910 >> (2 * idx)) & 3;
            f32x4 s = {0.f, 0.f, 0.f, 0.f};
#pragma unroll
            for (int kk = 0; kk < 4; ++kk) { const bf16x8 a = *(const LAS bf16x8*)(qs + (ti * 16 + fr) * 136 + kk * 32 + fq * 8), bb = *(const LAS bf16x8*)(ks + (si * 16 + fr) * 136 + kk * 32 + fq * 8);
                s = __builtin_amdgcn_mfma_f32_16x16x32_bf16(a, bb, s, 0, 0, 0); }
            const int sc = si * 16 + fr; const float wsv = fw[sc];
#pragma unroll
            for (int j = 0; j < 4; ++j) { const int tr = ti * 16 + fq * 4 + j; const float v = (sc <= tr) ? s[j] * __expf(wsv - fM[tr]) : 0.f; Sp[tr * 72 + sc] = f2bf(v); }
        }
        __syncthreads();
        if (w < 4) {
            const int ti = w; f32x4 o1[3], o2[3];
#pragma unroll
            for (int vt = 0; vt < 3; ++vt) { o1[vt] = (f32x4){0.f, 0.f, 0.f, 0.f}; o2[vt] = (f32x4){0.f, 0.f, 0.f, 0.f}; }
#pragma unroll
            for (int kk = 0; kk < 2; ++kk) { const bf16x8 a = *(const LAS bf16x8*)(Sp + (ti * 16 + fr) * 72 + kk * 32 + fq * 8);
#pragma unroll
                for (int vt = 0; vt < 3; ++vt) { const bf16x8 bb = *(const LAS bf16x8*)(vT + (vt * 16 + fr) * 72 + kk * 32 + fq * 8); o1[vt] = __builtin_amdgcn_mfma_f32_16x16x32_bf16(a, bb, o1[vt], 0, 0, 0); } }
#pragma unroll
            for (int kk = 0; kk < 4; ++kk) { const bf16x8 a = *(const LAS bf16x8*)(qs + (ti * 16 + fr) * 136 + kk * 32 + fq * 8);
#pragma unroll
                for (int vt = 0; vt < 3; ++vt) { const bf16x8 bb = *(const LAS bf16x8*)(Cb + (vt * 16 + fr) * 136 + kk * 32 + fq * 8); o2[vt] = __builtin_amdgcn_mfma_f32_16x16x32_bf16(a, bb, o2[vt], 0, 0, 0); } }
#pragma unroll
            for (int j = 0; j < 4; ++j) {
                const int tr = ti * 16 + fq * 4 + j; const float at = fa[tr], en = fen[tr];
                const float dn = o1[2][j] + at * o2[2][j]; const float den = __shfl(dn, lane & 48);
                const float inv = 1.0f / fmaxf(fabsf(den), en);
                const float h0 = (o1[0][j] + at * o2[0][j]) * inv, h1 = (o1[1][j] + at * o2[1][j]) * inv;
                bf16_t* dst = MIX + (tokbase + tr) * 2048 + h * 256 + js * 32 + fr;
                dst[0] = f2bf(h0); dst[16] = f2bf(h1);
                float s2 = h0 * h0 + h1 * h1;
                s2 += __shfl_xor(s2, 1); s2 += __shfl_xor(s2, 2); s2 += __shfl_xor(s2, 4); s2 += __shfl_xor(s2, 8);
                if (fr == 0) atomicAdd(ssqh + (tokbase + tr) * 4 + h, s2);
            }
        } else {
            const float a63 = fa[63];
#pragma unroll
            for (int vt = 0; vt < 3; ++vt)
#pragma unroll
                for (int k2 = 0; k2 < 2; ++k2) Cacc[vt][k2] = Cacc[vt][k2] * a63;
#pragma unroll
            for (int kk = 0; kk < 2; ++kk) {
                bf16x8 a[3], bb[2];
#pragma unroll
                for (int vt = 0; vt < 3; ++vt) a[vt] = *(const LAS bf16x8*)(vTd + (vt * 16 + fr) * 72 + kk * 32 + fq * 8);
#pragma unroll
                for (int k2 = 0; k2 < 2; ++k2) bb[k2] = *(const LAS bf16x8*)(kT + (((w - 4) * 2 + k2) * 16 + fr) * 72 + kk * 32 + fq * 8);
#pragma unroll
                for (int vt = 0; vt < 3; ++vt)
#pragma unroll
                    for (int k2 = 0; k2 < 2; ++k2) Cacc[vt][k2] = __builtin_amdgcn_mfma_f32_16x16x32_bf16(a[vt], bb[k2], Cacc[vt][k2], 0, 0, 0);
            }
        }
        __syncthreads();
    }
}

__device__ void phase_hm_finalize(const Params& P) {
    bf16_t* MIX = (bf16_t*)(P.ws + WS_MIX); const bf16_t* O = (const bf16_t*)(P.ws + WS_O); const float* ssqh = (const float*)(P.ws + WS_SMALL) + SM_SSQH;
    const float* gn = P.in[I_MLN];
    for (size_t i = (size_t)blockIdx.x * 512 + threadIdx.x; i < (size_t)T_TOK * 128; i += (size_t)gridDim.x * 512) {
        const size_t t = i >> 7; const int c = (int)(i & 127) * 8;
        const float rs = rs_of(ssqh[t * 4 + (c >> 8)], 1.0f / 256.0f);
        const u32x4 hv = *(const u32x4*)(MIX + t * 2048 + c), ov = *(const u32x4*)(O + t * 1024 + c);
        const f32x4 g0 = *(const f32x4*)(gn + c), g1 = *(const f32x4*)(gn + c + 4);
        u32x4 w;
        w.x = cvt_pk_bf16(bf_lo(hv.x) * rs * g0[0] * bf_lo(ov.x), bf_hi(hv.x) * rs * g0[1] * bf_hi(ov.x));
        w.y = cvt_pk_bf16(bf_lo(hv.y) * rs * g0[2] * bf_lo(ov.y), bf_hi(hv.y) * rs * g0[3] * bf_hi(ov.y));
        w.z = cvt_pk_bf16(bf_lo(hv.z) * rs * g1[0] * bf_lo(ov.z), bf_hi(hv.z) * rs * g1[1] * bf_hi(ov.z));
        w.w = cvt_pk_bf16(bf_lo(hv.w) * rs * g1[2] * bf_lo(ov.w), bf_hi(hv.w) * rs * g1[3] * bf_hi(ov.w));
        *(u32x4*)(MIX + t * 2048 + c) = w;
    }
}
__device__ void phase_final_norm(const Params& P) {
    const float* ssq = (const float*)(P.ws + WS_SMALL) + SM_SSQ3; const float* gn = P.in[I_FINN];
    for (size_t i = (size_t)blockIdx.x * 512 + threadIdx.x; i < (size_t)T_TOK * 512; i += (size_t)gridDim.x * 512) {
        const size_t t = i >> 9; const int c = (int)(i & 511) * 4;
        const float rs = rs_of(ssq[t], 1.0f / DM);
        f32x4 v = *(const f32x4*)(P.out + t * DM + c); const f32x4 g = *(const f32x4*)(gn + c);
        v = v * rs * g; *(f32x4*)(P.out + t * DM + c) = v;
    }
}

struct EpiE { float* E; __device__ __forceinline__ void operator()(int r, int c, const f32x4& v) const { *(f32x4*)(E + (size_t)r * 128 + c) = v; } };
struct EpiY { bf16_t* YS; int g, nt; __device__ __forceinline__ void operator()(int r, int c, const f32x4& v) const {
    const int n = nt * 128 + c, t = n >> 4, h = n & 15; u32x2 w; w.x = cvt_pk_bf16(gelu_tanh(v[0]), gelu_tanh(v[1])); w.y = cvt_pk_bf16(gelu_tanh(v[2]), gelu_tanh(v[3]));
    *(u32x2*)(YS + ((size_t)r * 16 + t) * 1024 + g * 16 + h) = w; } };

__global__ void __launch_bounds__(512, 2) fwd_megakernel(Params P) {
    extern __shared__ __attribute__((aligned(16))) unsigned char shm_raw[];
    LAS unsigned char* lds = (LAS unsigned char*)shm_raw;
    cg::grid_group grid = cg::this_grid();
    float* sm = (float*)(P.ws + WS_SMALL);
    bf16_t* XB = (bf16_t*)(P.ws + WS_XB); bf16_t* G = (bf16_t*)(P.ws + WS_G); bf16_t* MIX = (bf16_t*)(P.ws + WS_MIX);
    pg8::StaticOrder S;
    phase_prep(P, lds);
    grid.sync();
    { pg8::Gemm g{XB, (const bf16_t*)(P.ws + WS_W13_1), T_TOK, 2 * DFF, DM, DM, DM}; S.init(g.M, g.N, gridDim.x, blockIdx.x);
      EpiSwiGLU e{G, sm + SM_SSQ0}; pg8::gemm_phase(lds, g, S, e); }
    grid.sync();
    { pg8::Gemm g{G, (const bf16_t*)(P.ws + WS_W2_1), T_TOK, DM, DFF, DFF, DFF}; S.init(g.M, g.N, gridDim.x, blockIdx.x);
      EpiResid e{P.in[I_X], P.out, XB, sm + SM_SSQ1, 0.5f}; pg8::gemm_phase(lds, g, S, e); }
    grid.sync();
    { pg8::Gemm g{XB, (const bf16_t*)(P.ws + WS_WIN), T_TOK, 4096, DM, DM, DM}; S.init(g.M, g.N, gridDim.x, blockIdx.x);
      EpiWin e{(bf16_t*)(P.ws + WS_QK), (bf16_t*)(P.ws + WS_V), (bf16_t*)(P.ws + WS_O), (bf16_t*)(P.ws + WS_UX), sm + SM_SSQ1}; pg8::gemm_phase(lds, g, S, e); }
    phase_gates(P);
    grid.sync();
    for (int id = blockIdx.x; id < 512; id += gridDim.x) { const int g = id >> 3, mt = id & 7;
        EpiE e{(float*)(P.ws + WS_E) + ((size_t)g * 1024 + mt * 128) * 128};
        sgemm_unit(lds, (const bf16_t*)(P.ws + WS_UX) + ((size_t)g * 1024 + mt * 128) * 384, 384, (const bf16_t*)(P.ws + WS_BTE) + (size_t)g * 128 * 256, 256, 256, e); }
    grid.sync();
    phase_s5_scan(P);
    for (int it = blockIdx.x; it < 256; it += gridDim.x) mlstm_item(P, lds, it);
    grid.sync();
    for (int id = blockIdx.x; id < 1024; id += gridDim.x) { const int g = id >> 4, mt = (id >> 1) & 7, nt = id & 1;
        EpiY e{(bf16_t*)(P.ws + WS_YS) + (size_t)(mt * 128) * 16 * 1024, g, nt};
        sgemm_unit(lds, (const bf16_t*)(P.ws + WS_UX) + ((size_t)g * 1024 + mt * 128) * 384, 384, (const bf16_t*)(P.ws + WS_BTC) + ((size_t)g * 256 + nt * 128) * 384, 384, 384, e); }
    phase_hm_finalize(P);
    grid.sync();
    { pg8::Gemm g{(const bf16_t*)(P.ws + WS_YS), (const bf16_t*)(P.ws + WS_WGLU), T_TOK, 1024, 1024, 1024, 1024}; S.init(g.M, g.N, gridDim.x, blockIdx.x);
      EpiGLU e{(const bf16_t*)(P.ws + WS_YS), MIX, P.in[I_BGLU]}; pg8::gemm_phase(lds, g, S, e); }
    grid.sync();
    { pg8::Gemm g{MIX, (const bf16_t*)(P.ws + WS_WOUT), T_TOK, DM, DM, DM, DM}; S.init(g.M, g.N, gridDim.x, blockIdx.x);
      EpiResid e{P.out, P.out, XB, sm + SM_SSQ2, 1.0f}; pg8::gemm_phase(lds, g, S, e); }
    grid.sync();
    { pg8::Gemm g{XB, (const bf16_t*)(P.ws + WS_W13_2), T_TOK, 2 * DFF, DM, DM, DM}; S.init(g.M, g.N, gridDim.x, blockIdx.x);
      EpiSwiGLU e{G, sm + SM_SSQ2}; pg8::gemm_phase(lds, g, S, e); }
    grid.sync();
    { pg8::Gemm g{G, (const bf16_t*)(P.ws + WS_W2_2), T_TOK, DM, DFF, DFF, DFF}; S.init(g.M, g.N, gridDim.x, blockIdx.x);
      EpiResid e{P.out, P.out, nullptr, sm + SM_SSQ3, 0.5f}; pg8::gemm_phase(lds, g, S, e); }
    grid.sync();
    phase_final_norm(P);
}

extern "C" void kernel_launch(void* const* d_in, const int* in_sizes, int n_in, void* d_out, int out_size, void* d_ws, size_t ws_size, hipStream_t stream) {
    static int grid = 0;
    if (grid == 0) {
        if (n_in != 28 || ws_size < WS_END) { fprintf(stderr, "kernel_launch: unexpected n_in %d / ws_size %zu (need %zu)\n", n_in, ws_size, (size_t)WS_END); grid = -1; return; }
        int dev = 0, cus = 0, per_cu = 0;
        hipGetDevice(&dev); hipDeviceGetAttribute(&cus, hipDeviceAttributeMultiprocessorCount, dev);
        if (hipFuncSetAttribute((const void*)fwd_megakernel, hipFuncAttributeMaxDynamicSharedMemorySize, LDS_BYTES) != hipSuccess) { fprintf(stderr, "kernel_launch: hipFuncSetAttribute failed\n"); grid = -1; return; }
        if (hipOccupancyMaxActiveBlocksPerMultiprocessor(&per_cu, (const void*)fwd_megakernel, 512, LDS_BYTES) != hipSuccess || per_cu < 1) { fprintf(stderr, "kernel_launch: occupancy query gave %d\n", per_cu); per_cu = 1; }
        (void)hipGetLastError();
        grid = cus;
        if (grid > 256) grid = 256;
    }
    if (grid < 0) return;
    Params p{};
    for (int i = 0; i < 28; ++i) p.in[i] = (const float*)d_in[i];
    p.out = (float*)d_out; p.ws = (unsigned char*)d_ws;
    void* args[] = {&p};
    hipError_t e = hipLaunchCooperativeKernel((const void*)fwd_megakernel, dim3(grid), dim3(512), args, LDS_BYTES, stream);
    if (e != hipSuccess) fprintf(stderr, "cooperative launch failed: %s (grid %d)\n", hipGetErrorString(e), grid);
}
```

```cpp
#include <hip/hip_runtime.h>
#include <hip/hip_cooperative_groups.h>
#include <cstdio>
namespace cg = cooperative_groups;

#define LAS __attribute__((address_space(3)))
typedef unsigned short bf16_t;
typedef short bf16x8 __attribute__((ext_vector_type(8)));
typedef float f32x4 __attribute__((ext_vector_type(4)));
typedef float f32x2 __attribute__((ext_vector_type(2)));
typedef unsigned u32x4 __attribute__((ext_vector_type(4)));
typedef unsigned u32x2 __attribute__((ext_vector_type(2)));

constexpr int T_TOK = 16384, DM = 2048, DFF = 5632, SEQ = 2048;
constexpr int INC = 4104;
constexpr float EPS = 1e-6f;
constexpr int LDS_BYTES = 131072 + 64;
constexpr size_t MiB = 1024 * 1024;
constexpr size_t WS_W13_1 = 0, WS_W2_1 = 44 * MiB, WS_W13_2 = 66 * MiB, WS_W2_2 = 110 * MiB, WS_WIN = 132 * MiB, WS_WOUT = 148 * MiB,
                 WS_WGLU = 156 * MiB, WS_BTC = 158 * MiB, WS_BTE = 170 * MiB, WS_WG = 174 * MiB, WS_SMALL = 175 * MiB, WS_BAR = 177 * MiB,
                 WS_XB = 178 * MiB, WS_G = 242 * MiB, WS_MIX = 418 * MiB, WS_QKC = WS_W13_1  , WS_KT = 32 * MiB, WS_SP = 48 * MiB, WS_END = 482 * MiB;
constexpr size_t WS_QK = WS_G, WS_V = WS_G + 32 * MiB, WS_O = WS_G + 64 * MiB, WS_UX = WS_G + 96 * MiB, WS_E = WS_G + 144 * MiB, WS_YS = WS_QK;
constexpr size_t SM_SSQ0 = 0, SM_SSQ1 = 16384, SM_SSQ2 = 32768, SM_SSQ3 = 49152, SM_SSQH = 65536, SM_GATES = 131072, SM_LAML = 262144, SM_GS = 262144 + 8192, SM_ENDF = 262144 + 8192 + 196608;

struct Params { const float* in[28]; float* out; unsigned char* ws; };
enum { I_X = 0, I_F1N, I_F1W1, I_F1W3, I_F1W2, I_MIXN, I_WIN, I_CONVW, I_CONVB, I_BI, I_BF, I_MLN, I_LRE, I_LIM, I_LDT, I_BRE, I_BIM, I_CRE, I_CIM, I_DSK,
       I_WGLU, I_BGLU, I_WOUT, I_F2N, I_F2W1, I_F2W3, I_F2W2, I_FINN };

__device__ __forceinline__ unsigned cvt_pk_bf16(float lo, float hi) { unsigned r; asm volatile("v_cvt_pk_bf16_f32 %0, %1, %2" : "=v"(r) : "v"(lo), "v"(hi)); return r; }
__device__ __forceinline__ float bf_lo(unsigned u) { return __uint_as_float(u << 16); }
__device__ __forceinline__ float bf_hi(unsigned u) { return __uint_as_float(u & 0xffff0000u); }
__device__ __forceinline__ float bf2f(bf16_t b) { return __uint_as_float(((unsigned)b) << 16); }
__device__ __forceinline__ bf16_t f2bf(float f) { return (bf16_t)(cvt_pk_bf16(f, 0.f) & 0xffffu); }
__device__ __forceinline__ float frcp(float x) { return __builtin_amdgcn_rcpf(x); }
__device__ __forceinline__ float fexp(float x) { return __builtin_amdgcn_exp2f(x * 1.4426950408889634f); }
__device__ __forceinline__ float sigmoidf_(float x) { return frcp(1.0f + fexp(-x)); }
__device__ __forceinline__ float siluf_(float x) { return x * frcp(1.0f + fexp(-x)); }
__device__ __forceinline__ float gelu_tanh(float x) { const float u = 0.7978845608f * (x + 0.044715f * x * x * x); return x * frcp(1.0f + fexp(-2.0f * u)); }
__device__ __forceinline__ float rs_of(float ssq, float inv_n) { return rsqrtf(ssq * inv_n + EPS); }

namespace pg8 {
constexpr int BM = 256, BK = 64, HALF = 128, HTB = HALF * BK * 2, NXCD = 8, WGM = 8;
__host__ __device__ __forceinline__ int lds_byte(int r, int c) { const int st = (r >> 4) * 2 + (c >> 5), rr = r & 15, cc = c & 31, ob = rr * 64 + cc * 2; return st * 1024 + (ob ^ (((ob >> 9) & 1) << 5)); }
__host__ __device__ __forceinline__ void stage_rc(int b, int& R, int& C) { const int st = b / 1024, sb = b % 1024, swz = sb ^ (((sb >> 9) & 1) << 5); R = (st >> 1) * 16 + swz / 64; C = (st & 1) * 32 + (swz % 64) / 2; }
__host__ __device__ __forceinline__ int perm32(int rho) { const int n = rho >> 4, i = rho & 15; return 8 * (i >> 2) + 4 * n + (i & 3); }
struct Unit { int pm, pn; };
struct Gemm { const bf16_t* A; const bf16_t* Bt; int M, N, K, lda, ldb; };
struct StaticOrder {
    int nM, nN, nwg, G, c;
    __device__ void init(int M, int N, int G_, int c_) { nM = M / BM; nN = N / BM; nwg = nM * nN; G = G_; c = c_; }
    __device__ bool next(int i, Unit& u) const {
        const long L = (long)i * G + c; if (L >= nwg) return false;
        int wgid = (int)L; { const int q = nwg / NXCD, r = nwg % NXCD, xcd = wgid % NXCD, off = wgid / NXCD; wgid = (xcd < r ? xcd * (q + 1) : r * (q + 1) + (xcd - r) * q) + off; }
        const int nig = WGM * nN, gid = wgid / nig, fm = gid * WGM, gsz = (nM - fm) < WGM ? (nM - fm) : WGM;
        u.pm = fm + ((wgid % nig) % gsz); u.pn = (wgid % nig) / gsz; return true;
    }
};
template <class Epi>
__device__ __forceinline__ void gemm_phase(LAS unsigned char* lds, const Gemm g, const StaticOrder& S, const Epi& E) {
    int tid = threadIdx.x; asm volatile("" : "+v"(tid));
    const int wid = __builtin_amdgcn_readfirstlane(tid >> 6), lane = tid & 63, wr = wid >> 2, wc = wid & 3, fr = lane & 15, fq = lane >> 4;
    const int K = g.K, nt = K / BK;
    unsigned voffA[2], voffB[2];
#pragma unroll
    for (int i = 0; i < 2; ++i) { int R, C; stage_rc(tid * 16 + i * 8192, R, C); const int Rb = (R & ~31) + perm32(R & 31);
        voffA[i] = (unsigned)(R * g.lda + C) * 2u; voffB[i] = (unsigned)(Rb * g.ldb + C) * 2u; }
    const size_t kstep = (size_t)(BK * 2);
    const size_t hstepA = (size_t)HALF * g.lda * 2, hstepB = (size_t)HALF * g.ldb * 2;
    const size_t tstepA = 2 * hstepA, tstepB = 2 * hstepB;
    const unsigned ldsw = (unsigned)wid * 1024u;
    const int aoff = lds_byte(wr * 64 + fr, fq * 8), boff = lds_byte(wc * 32 + fr, fq * 8);
#define PG8_SA(b, h) (((b) * 2 + (h)) * HTB)
#define PG8_SB(b, h) ((4 + (b) * 2 + (h)) * HTB)
#define PG8_STAGE(bufoff, gbase, voff) do { _Pragma("unroll") for (int _i = 0; _i < 2; ++_i) \
        __builtin_amdgcn_global_load_lds((const unsigned*)((const char*)(gbase) + (voff)[_i]), (LAS unsigned*)(lds + (bufoff) + ldsw + _i * 8192), 16, 0, 0); } while (0)
#define PG8_LDA(dst, b, h) do { _Pragma("unroll") for (int m = 0; m < 4; ++m) _Pragma("unroll") for (int k = 0; k < 2; ++k) dst[m][k] = *(const LAS bf16x8*)(lds + PG8_SA(b, h) + aoff + m * 2048 + k * 1024); } while (0)
#define PG8_LDB(dst, b, h) do { _Pragma("unroll") for (int n = 0; n < 2; ++n) _Pragma("unroll") for (int k = 0; k < 2; ++k) dst[n][k] = *(const LAS bf16x8*)(lds + PG8_SB(b, h) + boff + n * 2048 + k * 1024); } while (0)
#define PG8_MMA(ai, bj, At, Bt) do { __builtin_amdgcn_s_setprio(1); _Pragma("unroll") for (int m = 0; m < 4; ++m) _Pragma("unroll") for (int n = 0; n < 2; ++n) _Pragma("unroll") for (int k = 0; k < 2; ++k) \
        acc[ai][bj][m][n] = __builtin_amdgcn_mfma_f32_16x16x32_bf16(Bt[n][k], At[m][k], acc[ai][bj][m][n], 0, 0, 0); __builtin_amdgcn_s_setprio(0); } while (0)
#define PG8_WAIT_V(n) asm volatile("s_waitcnt vmcnt(" #n ")" ::: "memory")
#define PG8_WAIT_L(n) asm volatile("s_waitcnt lgkmcnt(" #n ")" ::: "memory")
#define PG8_BAR __builtin_amdgcn_s_barrier()
#define PG8_SCHED __builtin_amdgcn_sched_barrier(0)
    Unit cur, nxt; int ui = 0;
    if (!S.next(0, cur)) return;
    f32x4 acc[2][2][4][2];
#pragma unroll
    for (int a = 0; a < 2; ++a)
#pragma unroll
        for (int b = 0; b < 2; ++b)
#pragma unroll
            for (int m = 0; m < 4; ++m)
#pragma unroll
                for (int n = 0; n < 2; ++n) acc[a][b][m][n] = (f32x4){0.f, 0.f, 0.f, 0.f};
    bf16x8 At[4][2], B0[2][2], B1[2][2];
    const char* cA = (const char*)g.A + (size_t)cur.pm * tstepA; const char* cB = (const char*)g.Bt + (size_t)cur.pn * tstepB;
    PG8_STAGE(PG8_SB(0, 0), cB, voffB); PG8_STAGE(PG8_SA(0, 0), cA, voffA); PG8_STAGE(PG8_SB(0, 1), cB + hstepB, voffB); PG8_STAGE(PG8_SA(0, 1), cA + hstepA, voffA);
    if (wr == 1) PG8_BAR;
    PG8_WAIT_V(4); PG8_BAR;
    PG8_STAGE(PG8_SB(1, 0), cB + kstep, voffB); PG8_STAGE(PG8_SA(1, 0), cA + kstep, voffA); PG8_STAGE(PG8_SB(1, 1), cB + hstepB + kstep, voffB);
    PG8_WAIT_V(6); PG8_BAR;
    for (;;) {
        const bool has_next = S.next(ui + 1, nxt);
        const char* nA = has_next ? (const char*)g.A + (size_t)nxt.pm * tstepA : cA; const char* nB = has_next ? (const char*)g.Bt + (size_t)nxt.pn * tstepB : cB;
        for (int t = 0; t < nt; t += 2) {
            const bool last = (t == nt - 2);
            const char* a1 = cA + (size_t)(t + 1) * kstep;
            const char* a2 = last ? nA : cA + (size_t)(t + 2) * kstep; const char* b2 = last ? nB : cB + (size_t)(t + 2) * kstep;
            const char* a3 = a2 + kstep; const char* b3 = b2 + kstep;
            PG8_LDB(B0, 0, 0); PG8_SCHED; PG8_LDA(At, 0, 0); PG8_STAGE(PG8_SA(1, 1), a1 + hstepA, voffA);
            PG8_WAIT_L(8); PG8_BAR; PG8_WAIT_L(0); PG8_MMA(0, 0, At, B0); PG8_BAR; PG8_SCHED;
            PG8_LDB(B1, 0, 1); PG8_STAGE(PG8_SB(0, 0), b2, voffB);
            PG8_BAR; PG8_WAIT_L(0); PG8_MMA(0, 1, At, B1); PG8_BAR;
            PG8_LDA(At, 0, 1); PG8_STAGE(PG8_SA(0, 0), a2, voffA);
            PG8_BAR; PG8_WAIT_L(0); PG8_MMA(1, 0, At, B0); PG8_BAR; PG8_SCHED;
            PG8_STAGE(PG8_SB(0, 1), b2 + hstepB, voffB);
            PG8_WAIT_V(6); PG8_BAR; PG8_MMA(1, 1, At, B1); PG8_BAR;
            PG8_LDB(B0, 1, 0); PG8_SCHED; PG8_LDA(At, 1, 0); PG8_STAGE(PG8_SA(0, 1), a2 + hstepA, voffA);
            PG8_WAIT_L(8); PG8_BAR; PG8_WAIT_L(0); PG8_MMA(0, 0, At, B0); PG8_BAR; PG8_SCHED;
            PG8_LDB(B1, 1, 1); PG8_STAGE(PG8_SB(1, 0), b3, voffB);
            PG8_BAR; PG8_WAIT_L(0); PG8_MMA(0, 1, At, B1); PG8_BAR;
            PG8_LDA(At, 1, 1); PG8_STAGE(PG8_SA(1, 0), a3, voffA);
            PG8_BAR; PG8_WAIT_L(0); PG8_MMA(1, 0, At, B0); PG8_BAR; PG8_SCHED;
            PG8_STAGE(PG8_SB(1, 1), b3 + hstepB, voffB);
            PG8_WAIT_V(6); PG8_BAR; PG8_MMA(1, 1, At, B1); PG8_BAR;
        }
        { int t2 = threadIdx.x; asm volatile("" : "+v"(t2)); const int w2 = __builtin_amdgcn_readfirstlane(t2 >> 6), l2 = t2 & 63; E(acc, cur, w2 >> 2, w2 & 3, l2 & 15, l2 >> 4); }
        if (!has_next) break;
#pragma unroll
        for (int a = 0; a < 2; ++a)
#pragma unroll
            for (int b = 0; b < 2; ++b)
#pragma unroll
                for (int m = 0; m < 4; ++m)
#pragma unroll
                    for (int n = 0; n < 2; ++n) acc[a][b][m][n] = (f32x4){0.f, 0.f, 0.f, 0.f};
        cur = nxt; cA = nA; cB = nB; ++ui;
    }
    PG8_WAIT_V(0);
    if (wr == 0) PG8_BAR;
    PG8_BAR;
#undef PG8_SA
#undef PG8_SB
#undef PG8_STAGE
#undef PG8_LDA
#undef PG8_LDB
#undef PG8_MMA
#undef PG8_WAIT_V
#undef PG8_WAIT_L
#undef PG8_BAR
#undef PG8_SCHED
}
}
using pg8::Unit;
typedef const f32x4 (&AccRef)[2][2][4][2];

struct CvtDesc { const float* src; const float* gain; bf16_t* dst; int ldsrc, col0, k0, lddst, nrow0; };
__device__ __forceinline__ void cvt_load(const CvtDesc& d, f32x4 (&v)[8], float (&g)[8]) {
    const int tid = threadIdx.x, r8 = tid >> 4, c4 = (tid & 15) * 4;
#pragma unroll
    for (int i = 0; i < 8; ++i) v[i] = *(const f32x4*)(d.src + (size_t)(d.k0 + r8 * 8 + i) * d.ldsrc + d.col0 + c4);
    if (d.gain) { const f32x4 g0 = *(const f32x4*)(d.gain + d.k0 + r8 * 8), g1 = *(const f32x4*)(d.gain + d.k0 + r8 * 8 + 4);
        g[0] = g0[0]; g[1] = g0[1]; g[2] = g0[2]; g[3] = g0[3]; g[4] = g1[0]; g[5] = g1[1]; g[6] = g1[2]; g[7] = g1[3]; }
    else {
#pragma unroll
        for (int i = 0; i < 8; ++i) g[i] = 1.0f; }
}
__device__ __forceinline__ void cvt_load4(const CvtDesc& d, f32x4 (&v)[4], f32x4& g) {
    const int tid = threadIdx.x, r4 = tid >> 4, c4 = (tid & 15) * 4;
#pragma unroll
    for (int i = 0; i < 4; ++i) v[i] = *(const f32x4*)(d.src + (size_t)(d.k0 + r4 * 4 + i) * d.ldsrc + d.col0 + c4);
    g = d.gain ? *(const f32x4*)(d.gain + d.k0 + r4 * 4) : (f32x4){1.f, 1.f, 1.f, 1.f};
}
__device__ __forceinline__ void cvt_store4(const CvtDesc& d, const f32x4 (&v)[4], const f32x4& g) {
    const int tid = threadIdx.x, r4 = tid >> 4, c4 = (tid & 15) * 4;
#pragma unroll
    for (int j = 0; j < 4; ++j) {
        u32x2 w; w.x = cvt_pk_bf16(v[0][j] * g[0], v[1][j] * g[1]); w.y = cvt_pk_bf16(v[2][j] * g[2], v[3][j] * g[3]);
        *(u32x2*)(d.dst + (size_t)(d.nrow0 + c4 + j) * d.lddst + d.k0 + r4 * 4) = w;
    }
}
__device__ __forceinline__ void cvt_store(const CvtDesc& d, const f32x4 (&v)[8], const float (&g)[8]) {
    const int tid = threadIdx.x, r8 = tid >> 4, c4 = (tid & 15) * 4;
#pragma unroll
    for (int j = 0; j < 4; ++j) {
        u32x4 w; w.x = cvt_pk_bf16(v[0][j] * g[0], v[1][j] * g[1]); w.y = cvt_pk_bf16(v[2][j] * g[2], v[3][j] * g[3]); w.z = cvt_pk_bf16(v[4][j] * g[4], v[5][j] * g[5]); w.w = cvt_pk_bf16(v[6][j] * g[6], v[7][j] * g[7]);
        *(u32x4*)(d.dst + (size_t)(d.nrow0 + c4 + j) * d.lddst + d.k0 + r8 * 8) = w;
    }
}
constexpr int CVT_T_W13 = 176 * 8, CVT_T_W2 = 32 * 22, CVT_T_WIN = 64 * 8, CVT_T_WOUT = 32 * 8, CVT_T_WGLU = 16 * 4;
constexpr int CVT_EARLY = CVT_T_W13 + CVT_T_W2 + CVT_T_WIN, CVT_TOT = CVT_EARLY + CVT_T_W13 + CVT_T_W2 + CVT_T_WOUT + CVT_T_WGLU;
__device__ __forceinline__ CvtDesc cvt_decode(const Params& P, int t) {
    CvtDesc d; int i = t; int f = 0;
    if (i >= CVT_EARLY) { i -= CVT_EARLY; f = 1; }
    if (i < CVT_T_W13) { const int nt = i >> 3, kt = i & 7; const int np = nt * 64, pn = np >> 8, bj = (np >> 7) & 1, ii = np & 127;
        { const float* a1 = f ? P.in[I_F2W1] : P.in[I_F1W1]; const float* a3 = f ? P.in[I_F2W3] : P.in[I_F1W3]; d.src = bj ? a3 : a1; } d.ldsrc = DFF; d.col0 = pn * 128 + ii; d.k0 = kt * 256; d.gain = f ? P.in[I_F2N] : P.in[I_F1N];
        d.dst = (bf16_t*)(P.ws + (f ? WS_W13_2 : WS_W13_1)); d.lddst = DM; d.nrow0 = np; return d; }
    i -= CVT_T_W13;
    if (i < CVT_T_W2) { const int nt = i / 22, kt = i % 22;
        d.src = f ? P.in[I_F2W2] : P.in[I_F1W2]; d.ldsrc = DM; d.col0 = nt * 64; d.k0 = kt * 256; d.gain = nullptr; d.dst = (bf16_t*)(P.ws + (f ? WS_W2_2 : WS_W2_1)); d.lddst = DFF; d.nrow0 = nt * 64; return d; }
    i -= CVT_T_W2;
    if (!f) { const int nt = i >> 3, kt = i & 7, np = nt * 64;
        d.src = P.in[I_WIN]; d.ldsrc = INC; d.col0 = np < 3072 ? np : np + 8; d.k0 = kt * 256; d.gain = P.in[I_MIXN]; d.dst = (bf16_t*)(P.ws + WS_WIN); d.lddst = DM; d.nrow0 = np; return d; }
    if (i < CVT_T_WOUT) { const int nt = i >> 3, kt = i & 7;
        d.src = P.in[I_WOUT]; d.ldsrc = DM; d.col0 = nt * 64; d.k0 = kt * 256; d.gain = nullptr; d.dst = (bf16_t*)(P.ws + WS_WOUT); d.lddst = DM; d.nrow0 = nt * 64; return d; }
    i -= CVT_T_WOUT;
    { const int nt = i >> 2, kt = i & 3;
        d.src = P.in[I_WGLU]; d.ldsrc = 1024; d.col0 = nt * 64; d.k0 = kt * 256; d.gain = nullptr; d.dst = (bf16_t*)(P.ws + WS_WGLU); d.lddst = 1024; d.nrow0 = nt * 64; return d; }
}

struct EpiSwiGLU {
    bf16_t* G; const float* ssq; const float* rw2; const float* rwin; const float* rmixn; unsigned char* rws;
    __device__ __forceinline__ void operator()(AccRef acc, const Unit& u, int wr, int wc, int fr, int fq) const {
        const int row0 = u.pm * 256 + wr * 64 + fr, col0 = u.pn * 128 + wc * 32 + 8 * fq;
        const int slot = u.pn * 64 + u.pm; const bool ride_on = rws != nullptr && slot < 2 * (CVT_T_W2 + CVT_T_WIN);
        CvtDesc cvd; f32x4 cvv[4]; f32x4 cvg;
        if (ride_on) {
            int i = slot >> 1;
            if (i < CVT_T_W2) { const int nt = i / 22, kt = i % 22; cvd.src = rw2; cvd.ldsrc = DM; cvd.col0 = nt * 64; cvd.k0 = kt * 256; cvd.gain = nullptr; cvd.dst = (bf16_t*)(rws + WS_W2_1); cvd.lddst = DFF; cvd.nrow0 = nt * 64; }
            else { i -= CVT_T_W2; const int nt = i >> 3, kt = i & 7, np = nt * 64; cvd.src = rwin; cvd.ldsrc = INC; cvd.col0 = np < 3072 ? np : np + 8; cvd.k0 = kt * 256; cvd.gain = rmixn; cvd.dst = (bf16_t*)(rws + WS_WIN); cvd.lddst = DM; cvd.nrow0 = np; }
            cvd.k0 += (slot & 1) * 128; cvt_load4(cvd, cvv, cvg);
        }
        float rsv[8];
#pragma unroll
        for (int i = 0; i < 8; ++i) rsv[i] = ssq[row0 + (i >> 2) * 128 + (i & 3) * 16];
#pragma unroll
        for (int i = 0; i < 8; ++i) rsv[i] = rs_of(rsv[i], 1.0f / DM);
#pragma unroll
        for (int ai = 0; ai < 2; ++ai)
#pragma unroll
            for (int m = 0; m < 4; ++m) {
                const int r = row0 + ai * 128 + m * 16; const float rs = rsv[ai * 4 + m];
                const float cexp = -1.4426950408889634f * rs, rs2 = rs * rs;
                f32x2 o[4];
#pragma unroll
                for (int n = 0; n < 2; ++n)
#pragma unroll
                    for (int jp = 0; jp < 2; ++jp) {
                        const f32x2 a1 = {acc[ai][0][m][n][2 * jp], acc[ai][0][m][n][2 * jp + 1]}, a3 = {acc[ai][1][m][n][2 * jp], acc[ai][1][m][n][2 * jp + 1]};
                        const f32x2 p = a1 * a3, t = a1 * cexp;
                        f32x2 e; e.x = __builtin_amdgcn_exp2f(t.x); e.y = __builtin_amdgcn_exp2f(t.y);
                        const f32x2 d = e + 1.0f;
                        f32x2 rr; rr.x = __builtin_amdgcn_rcpf(d.x); rr.y = __builtin_amdgcn_rcpf(d.y);
                        o[n * 2 + jp] = (p * rr) * rs2;
                    }
                u32x4 w; w.x = cvt_pk_bf16(o[0].x, o[0].y); w.y = cvt_pk_bf16(o[1].x, o[1].y); w.z = cvt_pk_bf16(o[2].x, o[2].y); w.w = cvt_pk_bf16(o[3].x, o[3].y);
                *(u32x4*)(G + (size_t)r * DFF + col0) = w;
            }
        if (ride_on) cvt_store4(cvd, cvv, cvg);
    }
};
template <bool BASE16> struct EpiResid {
    const float* base32; bf16_t* xb; float* ssq; float scale;
    __device__ __forceinline__ void operator()(AccRef acc, const Unit& u, int wr, int wc, int fr, int fq) const {
        const int row0 = u.pm * 256 + wr * 64 + fr, col0 = u.pn * 256 + wc * 32 + 8 * fq;
        f32x4 nb[4]; u32x4 nh[2]; float sv[8];
        { const size_t off = (size_t)row0 * DM + col0;
          if (BASE16) { nh[0] = *(const u32x4*)(xb + off); nh[1] = *(const u32x4*)(xb + off + 128); }
          else { nb[0] = *(const f32x4*)(base32 + off); nb[1] = *(const f32x4*)(base32 + off + 4); nb[2] = *(const f32x4*)(base32 + off + 128); nb[3] = *(const f32x4*)(base32 + off + 132); } }
#pragma unroll
        for (int i = 0; i < 8; ++i) {
            const int ai = i >> 2, m = i & 3; const int r = row0 + ai * 128 + m * 16;
            f32x4 cb[4];
            if (BASE16) {
#pragma unroll
                for (int q = 0; q < 2; ++q) { cb[q * 2] = (f32x4){bf_lo(nh[q].x), bf_hi(nh[q].x), bf_lo(nh[q].y), bf_hi(nh[q].y)}; cb[q * 2 + 1] = (f32x4){bf_lo(nh[q].z), bf_hi(nh[q].z), bf_lo(nh[q].w), bf_hi(nh[q].w)}; }
            } else {
#pragma unroll
                for (int q = 0; q < 4; ++q) cb[q] = nb[q];
            }
            if (i < 7) { const int r2 = row0 + ((i + 1) >> 2) * 128 + ((i + 1) & 3) * 16; const size_t off = (size_t)r2 * DM + col0;
                if (BASE16) { nh[0] = *(const u32x4*)(xb + off); nh[1] = *(const u32x4*)(xb + off + 128); }
                else { nb[0] = *(const f32x4*)(base32 + off); nb[1] = *(const f32x4*)(base32 + off + 4); nb[2] = *(const f32x4*)(base32 + off + 128); nb[3] = *(const f32x4*)(base32 + off + 132); } }
            float s = 0.f;
#pragma unroll
            for (int bj = 0; bj < 2; ++bj) {
                const size_t off = (size_t)r * DM + col0 + bj * 128;
                const f32x4 v0 = cb[bj * 2] + scale * acc[ai][bj][m][0], v1 = cb[bj * 2 + 1] + scale * acc[ai][bj][m][1];
                s += v0[0] * v0[0] + v0[1] * v0[1] + v0[2] * v0[2] + v0[3] * v0[3] + v1[0] * v1[0] + v1[1] * v1[1] + v1[2] * v1[2] + v1[3] * v1[3];
                u32x4 w; w.x = cvt_pk_bf16(v0[0], v0[1]); w.y = cvt_pk_bf16(v0[2], v0[3]); w.z = cvt_pk_bf16(v1[0], v1[1]); w.w = cvt_pk_bf16(v1[2], v1[3]); *(u32x4*)(xb + off) = w;
            }
            s += __shfl_xor(s, 16); s += __shfl_xor(s, 32);
            sv[i] = s;
        }
        if (fq == 0) {
#pragma unroll
            for (int i = 0; i < 8; ++i) atomicAdd(ssq + row0 + (i >> 2) * 128 + (i & 3) * 16, sv[i]);
        }
    }
};
struct EpiWin {
    bf16_t* QK; bf16_t* V; bf16_t* O; bf16_t* UX; const float* ssq;
    __device__ __forceinline__ void operator()(AccRef acc, const Unit& u, int wr, int wc, int fr, int fq) const {
        const int row0 = u.pm * 256 + wr * 64 + fr, region = u.pn >> 2, colr0 = (u.pn & 3) * 256 + wc * 32 + 8 * fq;
        float rsv[8];
#pragma unroll
        for (int i = 0; i < 8; ++i) rsv[i] = ssq[row0 + (i >> 2) * 128 + (i & 3) * 16];
#pragma unroll
        for (int i = 0; i < 8; ++i) rsv[i] = rs_of(rsv[i], 1.0f / DM);
#pragma unroll
        for (int ai = 0; ai < 2; ++ai)
#pragma unroll
            for (int m = 0; m < 4; ++m) {
                const int r = row0 + ai * 128 + m * 16; const float rs = rsv[ai * 4 + m];
#pragma unroll
                for (int bj = 0; bj < 2; ++bj) {
                    const int colr = colr0 + bj * 128;
                    f32x4 v0 = rs * acc[ai][bj][m][0], v1 = rs * acc[ai][bj][m][1];
                    if (region == 2) {
#pragma unroll
                        for (int j = 0; j < 4; ++j) { v0[j] = sigmoidf_(v0[j]); v1[j] = sigmoidf_(v1[j]); } }
                    u32x4 w; w.x = cvt_pk_bf16(v0[0], v0[1]); w.y = cvt_pk_bf16(v0[2], v0[3]); w.z = cvt_pk_bf16(v1[0], v1[1]); w.w = cvt_pk_bf16(v1[2], v1[3]);
                    bf16_t* dst;
                    if (region == 0) dst = QK + (size_t)r * 1024 + colr;
                    else if (region == 1) dst = V + (size_t)r * 1024 + colr;
                    else if (region == 2) dst = O + (size_t)r * 1024 + colr;
                    else dst = UX + ((size_t)(colr >> 4) * 1024 + (r >> 4)) * 384 + (r & 15) * 16 + (colr & 15);
                    *(u32x4*)dst = w;
                }
            }
    }
};
struct EpiGLU {
    const bf16_t* YS; bf16_t* MIX; const float* bias;
    __device__ __forceinline__ void operator()(AccRef acc, const Unit& u, int wr, int wc, int fr, int fq) const {
        const int row0 = u.pm * 256 + wr * 64 + fr, col0 = u.pn * 256 + wc * 32 + 8 * fq;
        f32x4 bv[4]; u32x4 yv[16];
#pragma unroll
        for (int q = 0; q < 4; ++q) bv[q] = *(const f32x4*)(bias + col0 + (q >> 1) * 128 + (q & 1) * 4);
#pragma unroll
        for (int i = 0; i < 8; ++i)
#pragma unroll
            for (int bj = 0; bj < 2; ++bj) yv[i * 2 + bj] = *(const u32x4*)(YS + (size_t)(row0 + (i >> 2) * 128 + (i & 3) * 16) * 1024 + col0 + bj * 128);
#pragma unroll
        for (int ai = 0; ai < 2; ++ai)
#pragma unroll
            for (int m = 0; m < 4; ++m) {
                const int r = row0 + ai * 128 + m * 16;
#pragma unroll
                for (int bj = 0; bj < 2; ++bj) {
                    const int c = col0 + bj * 128;
                    const u32x4 y = yv[(ai * 4 + m) * 2 + bj];
                    const f32x4 a0 = acc[ai][bj][m][0] + bv[bj * 2], a1 = acc[ai][bj][m][1] + bv[bj * 2 + 1];
                    u32x4 w;
                    w.x = cvt_pk_bf16(bf_lo(y.x) * sigmoidf_(a0[0]), bf_hi(y.x) * sigmoidf_(a0[1]));
                    w.y = cvt_pk_bf16(bf_lo(y.y) * sigmoidf_(a0[2]), bf_hi(y.y) * sigmoidf_(a0[3]));
                    w.z = cvt_pk_bf16(bf_lo(y.z) * sigmoidf_(a1[0]), bf_hi(y.z) * sigmoidf_(a1[1]));
                    w.w = cvt_pk_bf16(bf_lo(y.w) * sigmoidf_(a1[2]), bf_hi(y.w) * sigmoidf_(a1[3]));
                    *(u32x4*)(MIX + (size_t)r * 2048 + 1024 + c) = w;
                }
            }
    }
};

template <class Epi>
__device__ __forceinline__ void sgemm_unit(LAS unsigned char* lds, const bf16_t* A, int lda, const bf16_t* Bt, int ldb, int K, const Epi& E) {
    const int tid = threadIdx.x, w = tid >> 6, lane = tid & 63, fr = lane & 15, fq = lane >> 4, wr = w >> 2, wc = w & 3;
    LAS bf16_t* As = (LAS bf16_t*)lds; LAS bf16_t* Bs = (LAS bf16_t*)(lds + 34816);
    f32x4 acc[4][2];
#pragma unroll
    for (int m = 0; m < 4; ++m)
#pragma unroll
        for (int n = 0; n < 2; ++n) acc[m][n] = (f32x4){0.f, 0.f, 0.f, 0.f};
    u32x4 ra[4], rb[4];
    const int lr0 = tid >> 4, lc = (tid & 15) * 8;
#pragma unroll
    for (int i = 0; i < 4; ++i) { ra[i] = *(const u32x4*)(A + (size_t)(lr0 + 32 * i) * lda + lc); rb[i] = *(const u32x4*)(Bt + (size_t)(lr0 + 32 * i) * ldb + lc); }
    for (int k0 = 0; k0 < K; k0 += 128) {
        __syncthreads();
#pragma unroll
        for (int i = 0; i < 4; ++i) { *(LAS u32x4*)(As + (lr0 + 32 * i) * 136 + lc) = ra[i]; *(LAS u32x4*)(Bs + (lr0 + 32 * i) * 136 + lc) = rb[i]; }
        __syncthreads();
        if (k0 + 128 < K) {
#pragma unroll
            for (int i = 0; i < 4; ++i) { ra[i] = *(const u32x4*)(A + (size_t)(lr0 + 32 * i) * lda + k0 + 128 + lc); rb[i] = *(const u32x4*)(Bt + (size_t)(lr0 + 32 * i) * ldb + k0 + 128 + lc); }
        }
#pragma unroll
        for (int kk = 0; kk < 4; ++kk) {
            bf16x8 af[4], bfv[2];
#pragma unroll
            for (int m = 0; m < 4; ++m) af[m] = *(const LAS bf16x8*)(As + (wr * 64 + m * 16 + fr) * 136 + kk * 32 + fq * 8);
#pragma unroll
            for (int n = 0; n < 2; ++n) bfv[n] = *(const LAS bf16x8*)(Bs + (wc * 32 + n * 16 + fr) * 136 + kk * 32 + fq * 8);
#pragma unroll
            for (int m = 0; m < 4; ++m)
#pragma unroll
                for (int n = 0; n < 2; ++n) acc[m][n] = __builtin_amdgcn_mfma_f32_16x16x32_bf16(bfv[n], af[m], acc[m][n], 0, 0, 0);
        }
    }
#pragma unroll
    for (int m = 0; m < 4; ++m)
#pragma unroll
        for (int n = 0; n < 2; ++n) E(wr * 64 + m * 16 + fr, wc * 32 + n * 16 + 4 * fq, acc[m][n]);
    __syncthreads();
}

__device__ void s5_prep_group(const Params& P, LAS unsigned char* lds, int g) {
    const int tid = threadIdx.x;
    LAS float* Pw = (LAS float*)lds;
    LAS float* Bb = Pw + 17 * 128;
    LAS float* Cc = Bb + 2048;
    LAS float* Kt = Cc + 2048;
    const float dt = __expf(P.in[I_LDT][g]);
    if (tid < 64) {
        const int p = tid; const float lr = P.in[I_LRE][g * 64 + p], li = P.in[I_LIM][g * 64 + p];
        for (int tau = 0; tau <= 16; ++tau) { const float e = __expf(lr * dt * tau); float sn, cs; sincosf(li * dt * tau, &sn, &cs); Pw[(tau * 64 + p) * 2] = e * cs; Pw[(tau * 64 + p) * 2 + 1] = e * sn; }
        float* laml = (float*)(P.ws + WS_SMALL) + SM_LAML;
        laml[(g * 64 + p) * 2] = Pw[(16 * 64 + p) * 2]; laml[(g * 64 + p) * 2 + 1] = Pw[(16 * 64 + p) * 2 + 1];
    }
    for (int i = tid; i < 1024; i += 512) {
        const int p = i >> 4; const float lr = P.in[I_LRE][g * 64 + p], li = P.in[I_LIM][g * 64 + p];
        const float e = __expf(lr * dt); float sn, cs; sincosf(li * dt, &sn, &cs);
        const float nr = e * cs - 1.0f, ni = e * sn, den = 1.0f / (lr * lr + li * li);
        const float fr_ = (nr * lr + ni * li) * den, fi_ = (ni * lr - nr * li) * den;
        const float br = P.in[I_BRE][(size_t)g * 1024 + i], bi = P.in[I_BIM][(size_t)g * 1024 + i];
        Bb[i * 2] = fr_ * br - fi_ * bi; Bb[i * 2 + 1] = fr_ * bi + fi_ * br;
        Cc[i * 2] = P.in[I_CRE][(size_t)g * 1024 + i]; Cc[i * 2 + 1] = P.in[I_CIM][(size_t)g * 1024 + i];
    }
    __syncthreads();
    for (int i = tid; i < 4096; i += 512) {
        const int tau = i >> 8, h = (i >> 4) & 15, hp = i & 15; float s = 0.f;
        for (int p = 0; p < 64; ++p) {
            const float cr = Cc[(h * 64 + p) * 2], ci = Cc[(h * 64 + p) * 2 + 1], pr = Pw[(tau * 64 + p) * 2], pi = Pw[(tau * 64 + p) * 2 + 1];
            const float zr = cr * pr - ci * pi, zi = cr * pi + ci * pr;
            s += zr * Bb[(p * 16 + hp) * 2] - zi * Bb[(p * 16 + hp) * 2 + 1];
        }
        if (tau == 0 && h == hp) s += P.in[I_DSK][g * 16 + h];
        Kt[i] = s;
    }
    __syncthreads();
    bf16_t* btc = (bf16_t*)(P.ws + WS_BTC) + (size_t)g * 256 * 384;
    for (int i = tid; i < 256 * 48; i += 512) {
        const int n = i / 48, k0 = (i % 48) * 8, t = n >> 4, h = n & 15; float o[8];
#pragma unroll
        for (int e = 0; e < 8; ++e) {
            const int k = k0 + e;
            if (k < 256) { const int s = k >> 4, hp = k & 15; o[e] = (t >= s) ? Kt[((t - s) * 16 + h) * 16 + hp] : 0.f; }
            else { const int kk = k - 256, ri = kk >> 6, p = kk & 63; const float cr = Cc[(h * 64 + p) * 2], ci = Cc[(h * 64 + p) * 2 + 1], pr = Pw[((t + 1) * 64 + p) * 2], pi = Pw[((t + 1) * 64 + p) * 2 + 1];
                o[e] = ri == 0 ? (cr * pr - ci * pi) : -(cr * pi + ci * pr); }
        }
        u32x4 w; w.x = cvt_pk_bf16(o[0], o[1]); w.y = cvt_pk_bf16(o[2], o[3]); w.z = cvt_pk_bf16(o[4], o[5]); w.w = cvt_pk_bf16(o[6], o[7]);
        *(u32x4*)(btc + (size_t)n * 384 + k0) = w;
    }
    bf16_t* bte = (bf16_t*)(P.ws + WS_BTE) + (size_t)g * 128 * 256;
    for (int i = tid; i < 128 * 32; i += 512) {
        const int n = i >> 5, k0 = (i & 31) * 8, ri = n >> 6, p = n & 63; float o[8];
#pragma unroll
        for (int e = 0; e < 8; ++e) {
            const int k = k0 + e, s = k >> 4, hp = k & 15;
            const float pr = Pw[((15 - s) * 64 + p) * 2], pi = Pw[((15 - s) * 64 + p) * 2 + 1], br = Bb[(p * 16 + hp) * 2], bi = Bb[(p * 16 + hp) * 2 + 1];
            o[e] = ri == 0 ? (pr * br - pi * bi) : (pr * bi + pi * br);
        }
        u32x4 w; w.x = cvt_pk_bf16(o[0], o[1]); w.y = cvt_pk_bf16(o[2], o[3]); w.z = cvt_pk_bf16(o[4], o[5]); w.w = cvt_pk_bf16(o[6], o[7]);
        *(u32x4*)(bte + (size_t)n * 256 + k0) = w;
    }
    __syncthreads();
}

__device__ void phase_prep(const Params& P, LAS unsigned char* lds) {
    const int tid = threadIdx.x, bid = blockIdx.x, nb = gridDim.x;
    float* sm = (float*)(P.ws + WS_SMALL);
    for (int i = bid * 512 + tid; i < 49152 + 65536; i += nb * 512) sm[SM_SSQ1 + i] = 0.f;
    { bf16_t* wg = (bf16_t*)(P.ws + WS_WG);
      for (int i = bid * 512 + tid; i < 16 * 2048; i += nb * 512) { const int n = i >> 11, k = i & 2047; wg[i] = n < 8 ? f2bf(P.in[I_WIN][(size_t)k * INC + 3072 + n] * P.in[I_MIXN][k]) : (bf16_t)0; } }
    { const int w = tid >> 6, lane = tid & 63; bf16_t* xb = (bf16_t*)(P.ws + WS_XB);
      for (int row = bid * 8 + w; row < T_TOK; row += 2 * nb * 8) {
          const int row2 = row + nb * 8; const bool has2 = row2 < T_TOK;
          const float* xr = P.in[I_X] + (size_t)row * DM; const float* xr2 = P.in[I_X] + (size_t)(has2 ? row2 : row) * DM;
          f32x4 va[8], vb[8];
#pragma unroll
          for (int it = 0; it < 8; ++it) { va[it] = *(const f32x4*)(xr + (it * 64 + lane) * 4); vb[it] = *(const f32x4*)(xr2 + (it * 64 + lane) * 4); }
          float s = 0.f, s2 = 0.f;
#pragma unroll
          for (int it = 0; it < 8; ++it) { const f32x4 v = va[it], u = vb[it];
              s += v[0] * v[0] + v[1] * v[1] + v[2] * v[2] + v[3] * v[3]; s2 += u[0] * u[0] + u[1] * u[1] + u[2] * u[2] + u[3] * u[3];
              u32x2 o; o.x = cvt_pk_bf16(v[0], v[1]); o.y = cvt_pk_bf16(v[2], v[3]); *(u32x2*)(xb + (size_t)row * DM + (it * 64 + lane) * 4) = o;
              if (has2) { u32x2 o2; o2.x = cvt_pk_bf16(u[0], u[1]); o2.y = cvt_pk_bf16(u[2], u[3]); *(u32x2*)(xb + (size_t)row2 * DM + (it * 64 + lane) * 4) = o2; } }
#pragma unroll
          for (int o = 32; o >= 1; o >>= 1) { s += __shfl_xor(s, o); s2 += __shfl_xor(s2, o); }
          if (lane == 0) { sm[SM_SSQ0 + row] = s; if (has2) sm[SM_SSQ0 + row2] = s2; }
      } }
    for (int g = bid; g < 64; g += nb) s5_prep_group(P, lds, g);
    const int nskip = nb > 128 ? 64 : 0, nwk = nb - nskip;
    if (bid >= nskip)
    for (int t = bid - nskip; t < CVT_T_W13; t += 2 * nwk) {
        const CvtDesc d0 = cvt_decode(P, t); f32x4 v0[8]; float g0[8]; cvt_load(d0, v0, g0);
        if (t + nwk < CVT_T_W13) { const CvtDesc d1 = cvt_decode(P, t + nwk); f32x4 v1[8]; float g1[8]; cvt_load(d1, v1, g1); cvt_store(d0, v0, g0); cvt_store(d1, v1, g1); }
        else cvt_store(d0, v0, g0);
    }
}

__device__ void phase_gates(const Params& P, LAS unsigned char* lds) {
    const int tid = threadIdx.x, w = tid >> 6, lane = tid & 63, fr = lane & 15, fq = lane >> 4, half = w & 1;
    const bf16_t* xb = (const bf16_t*)(P.ws + WS_XB); const bf16_t* wg = (const bf16_t*)(P.ws + WS_WG);
    float* sm = (float*)(P.ws + WS_SMALL); LAS f32x4* xch = (LAS f32x4*)lds;
    for (int t0 = blockIdx.x * 4; t0 < T_TOK / 16; t0 += gridDim.x * 4) {
        const int task = t0 + (w >> 1); const bool valid = task < T_TOK / 16;
        const int tok0 = (valid ? task : 0) * 16; f32x4 acc = {0.f, 0.f, 0.f, 0.f};
        const bf16_t* ap = xb + (size_t)(tok0 + fr) * DM + half * 1024 + fq * 8; const bf16_t* bp = wg + (size_t)fr * DM + half * 1024 + fq * 8;
#pragma unroll 16
        for (int kk = 0; kk < 32; ++kk) { const bf16x8 a = *(const bf16x8*)(ap + kk * 32), b = *(const bf16x8*)(bp + kk * 32); acc = __builtin_amdgcn_mfma_f32_16x16x32_bf16(a, b, acc, 0, 0, 0); }
        __syncthreads();
        if (half) xch[(w >> 1) * 64 + lane] = acc;
        __syncthreads();
        if (!half && valid && fr < 8) {
            acc += xch[(w >> 1) * 64 + lane];
            const float bias = fr < 4 ? P.in[I_BI][fr] : P.in[I_BF][fr - 4];
#pragma unroll
            for (int j = 0; j < 4; ++j) { const int tok = tok0 + fq * 4 + j; float v = rs_of(sm[SM_SSQ1 + tok], 1.0f / DM) * acc[j] + bias;
                if (fr >= 4) v = fminf(v, 0.f) - log1pf(__expf(-fabsf(v)));
                sm[SM_GATES + (size_t)tok * 8 + fr] = v; }
        }
    }
}

__device__ void phase_s5_scan(const Params& P) {
    const int tid = threadIdx.x; if (tid >= 128) return;
    const float* __restrict__ E = (const float*)(P.ws + WS_E); bf16_t* __restrict__ UX = (bf16_t*)(P.ws + WS_UX); const float* laml = (const float*)(P.ws + WS_SMALL) + SM_LAML;
    for (int id = blockIdx.x * 128 + tid; id < 8 * 64 * 64; id += gridDim.x * 128) {
        const int p = id & 63, g = (id >> 6) & 63, b = id >> 12;
        const float lr = laml[(g * 64 + p) * 2], li = laml[(g * 64 + p) * 2 + 1]; float xr = 0.f, xi = 0.f;
        const size_t row0 = (size_t)g * 1024 + b * 128;
        for (int c0 = 0; c0 < 128; c0 += 16) {
            float er[16], ei[16];
#pragma unroll
            for (int c = 0; c < 16; ++c) { er[c] = E[(row0 + c0 + c) * 128 + p]; ei[c] = E[(row0 + c0 + c) * 128 + 64 + p]; }
#pragma unroll
            for (int c = 0; c < 16; ++c) {
                UX[(row0 + c0 + c) * 384 + 256 + p] = f2bf(xr); UX[(row0 + c0 + c) * 384 + 320 + p] = f2bf(xi);
                const float nr = lr * xr - li * xi + er[c], ni = lr * xi + li * xr + ei[c]; xr = nr; xi = ni;
            }
        }
    }
}

__device__ void phase_mix_pre(const Params& P, LAS unsigned char* lds) {
    const int tid = threadIdx.x, w = __builtin_amdgcn_readfirstlane(tid >> 6), lane = tid & 63, fr = lane & 15, fq = lane >> 4;
    LAS bf16_t* qs = (LAS bf16_t*)lds; LAS bf16_t* ks = (LAS bf16_t*)(lds + 17408); LAS float* fwp = (LAS float*)(lds + 34816);
    const float* gates = (const float*)(P.ws + WS_SMALL) + SM_GATES; bf16_t* SPg = (bf16_t*)(P.ws + WS_SP);
    const bf16_t* QK = (const bf16_t*)(P.ws + WS_QK); bf16_t* QKC = (bf16_t*)(P.ws + WS_QKC); bf16_t* KT = (bf16_t*)(P.ws + WS_KT);
    const int dg = tid & 31, isK = dg >> 4, d0 = (dg & 15) * 8, tl = tid >> 5;
    const float qscale = isK ? 1.0f : 0.08838834764831845f;
#define MP_LOAD_RAW(dst, tk) do { const int b_ = (tk) >> 7, h_ = ((tk) >> 5) & 3, t0_ = ((tk) & 31) * 64, cc_ = (isK ? 512 : 0) + h_ * 128 + d0; \
        _Pragma("unroll") for (int i_ = 0; i_ < 7; ++i_) { const int pos_ = t0_ + tl * 4 - 3 + i_; dst[i_] = pos_ >= 0 ? *(const u32x4*)(QK + ((size_t)b_ * SEQ + pos_) * 1024 + cc_) : (u32x4){0u, 0u, 0u, 0u}; } } while (0)
    float cw[4][8], cb[8]; int h_prev = -1;
    u32x4 raw[7];
    if ((int)blockIdx.x < 1024) MP_LOAD_RAW(raw, (int)blockIdx.x);
    for (int task = blockIdx.x; task < 1024; task += gridDim.x) {
        const int b = task >> 7, h = (task >> 5) & 3, c = task & 31, t0 = c * 64;
        const int convcol = (isK ? 512 : 0) + h * 128 + d0;
        if (h != h_prev) {
            h_prev = h;
#pragma unroll
            for (int j = 0; j < 4; ++j) { const f32x4 a0 = *(const f32x4*)(P.in[I_CONVW] + j * 1024 + convcol), a1 = *(const f32x4*)(P.in[I_CONVW] + j * 1024 + convcol + 4);
                cw[j][0] = a0[0]; cw[j][1] = a0[1]; cw[j][2] = a0[2]; cw[j][3] = a0[3]; cw[j][4] = a1[0]; cw[j][5] = a1[1]; cw[j][6] = a1[2]; cw[j][7] = a1[3]; }
            { const f32x4 a0 = *(const f32x4*)(P.in[I_CONVB] + convcol), a1 = *(const f32x4*)(P.in[I_CONVB] + convcol + 4);
                cb[0] = a0[0]; cb[1] = a0[1]; cb[2] = a0[2]; cb[3] = a0[3]; cb[4] = a1[0]; cb[5] = a1[1]; cb[6] = a1[2]; cb[7] = a1[3]; }
        }
        u32x4 nraw[7];
#pragma unroll
        for (int i = 0; i < 7; ++i) nraw[i] = (u32x4){0u, 0u, 0u, 0u};
        if (task + (int)gridDim.x < 1024) MP_LOAD_RAW(nraw, task + (int)gridDim.x);
        float o[4][8];
#pragma unroll
        for (int tt = 0; tt < 4; ++tt) {
#pragma unroll
            for (int e = 0; e < 8; ++e) o[tt][e] = cb[e];
#pragma unroll
            for (int j = 0; j < 4; ++j) { const u32x4 x = raw[tt + j];
                o[tt][0] += cw[j][0] * bf_lo(x.x); o[tt][1] += cw[j][1] * bf_hi(x.x); o[tt][2] += cw[j][2] * bf_lo(x.y); o[tt][3] += cw[j][3] * bf_hi(x.y);
                o[tt][4] += cw[j][4] * bf_lo(x.z); o[tt][5] += cw[j][5] * bf_hi(x.z); o[tt][6] += cw[j][6] * bf_lo(x.w); o[tt][7] += cw[j][7] * bf_hi(x.w); }
#pragma unroll
            for (int e = 0; e < 8; ++e) o[tt][e] = siluf_(o[tt][e]) * qscale;
            u32x4 wv; wv.x = cvt_pk_bf16(o[tt][0], o[tt][1]); wv.y = cvt_pk_bf16(o[tt][2], o[tt][3]); wv.z = cvt_pk_bf16(o[tt][4], o[tt][5]); wv.w = cvt_pk_bf16(o[tt][6], o[tt][7]);
            *(u32x4*)(QKC + ((size_t)b * SEQ + t0 + tl * 4 + tt) * 1024 + convcol) = wv;
            *(LAS u32x4*)((isK ? ks : qs) + (tl * 4 + tt) * 136 + d0) = wv;
        }
        if (isK) {
            bf16_t* kt = KT + (size_t)task * 8192 + tl * 4;
#pragma unroll
            for (int e = 0; e < 8; ++e) { u32x2 wv; wv.x = cvt_pk_bf16(o[0][e], o[1][e]); wv.y = cvt_pk_bf16(o[2][e], o[3][e]); *(u32x2*)(kt + (d0 + e) * 64) = wv; }
        }
        if (w == 0) {
            const size_t tok = (size_t)b * SEQ + t0 + lane; const float li = gates[tok * 8 + h]; float x = gates[tok * 8 + 4 + h];
#pragma unroll
            for (int off = 1; off < 64; off <<= 1) { const float t = __shfl_up(x, off); if (lane >= off) x += t; }
            const float wv = li - x; float pm = wv;
#pragma unroll
            for (int off = 1; off < 64; off <<= 1) { const float t = __shfl_up(pm, off); if (lane >= off) pm = fmaxf(pm, t); }
            fwp[lane] = wv; fwp[64 + lane] = pm;
        }
        __syncthreads();
        for (int idx = w; idx < 16; idx += 8) {
            bf16_t* spt = SPg + (size_t)task * 4096;
            if (idx < 10) {
                const int ti = (0xFFA94 >> (2 * idx)) & 3, si = (0xE4910 >> (2 * idx)) & 3;
                f32x4 sT = {0.f, 0.f, 0.f, 0.f};
#pragma unroll
                for (int kk = 0; kk < 4; ++kk) { const bf16x8 a = *(const LAS bf16x8*)(ks + (si * 16 + fr) * 136 + kk * 32 + fq * 8), bb = *(const LAS bf16x8*)(qs + (ti * 16 + fr) * 136 + kk * 32 + fq * 8);
                    sT = __builtin_amdgcn_mfma_f32_16x16x32_bf16(a, bb, sT, 0, 0, 0); }
                const int tr = ti * 16 + fr, sc0 = si * 16 + fq * 4; const float pmt = fwp[64 + tr];
                const f32x4 w4 = *(const LAS f32x4*)(fwp + sc0);
                float vv[4];
#pragma unroll
                for (int j = 0; j < 4; ++j) vv[j] = (sc0 + j <= tr) ? sT[j] * fexp(w4[j] - pmt) : 0.f;
                u32x2 pk; pk.x = cvt_pk_bf16(vv[0], vv[1]); pk.y = cvt_pk_bf16(vv[2], vv[3]);
                *(u32x2*)(spt + tr * 64 + sc0) = pk;
            } else {
                const int k = idx - 10, ti = (k >= 3) + (k >= 5), si = k < 3 ? k + 1 : (k < 5 ? k - 1 : 3);
                *(u32x2*)(spt + (ti * 16 + fr) * 64 + si * 16 + fq * 4) = (u32x2){0u, 0u};
            }
        }
        __syncthreads();
#pragma unroll
        for (int i = 0; i < 7; ++i) raw[i] = nraw[i];
    }
#undef MP_LOAD_RAW
}

#define LDS_BARRIER() do { asm volatile("s_waitcnt lgkmcnt(0)" ::: "memory"); __builtin_amdgcn_s_barrier(); asm volatile("" ::: "memory"); } while (0)
__device__ void mlstm_item(const Params& P, LAS unsigned char* lds, int item, float* ssqh) {
    const int tid = threadIdx.x, w = __builtin_amdgcn_readfirstlane(tid >> 6), lane = tid & 63, fr = lane & 15, fq = lane >> 4;
    const int pair = (item & 7) * 4 + (item >> 6), js = (item >> 3) & 7, b = pair >> 2, h = pair & 3;
    LAS bf16_t* qs = (LAS bf16_t*)(lds);
    LAS bf16_t* ks = (LAS bf16_t*)(lds + 17408);
    LAS bf16_t* kT = (LAS bf16_t*)(lds + 34816);
    LAS bf16_t* vT = (LAS bf16_t*)(lds + 53248);
    LAS bf16_t* vTd = (LAS bf16_t*)(lds + 60160);
    LAS bf16_t* Sp = (LAS bf16_t*)(lds + 67072);
    LAS bf16_t* Cb = (LAS bf16_t*)(lds + 76288);
    LAS float* fw = (LAS float*)(lds + 89344);
    LAS float* fM = fw + 64; LAS float* fa = fw + 128; LAS float* fen = fw + 192; LAS float* fd63 = fw + 256;
    const bf16_t* QKC = (const bf16_t*)(P.ws + WS_QKC); const bf16_t* KT = (const bf16_t*)(P.ws + WS_KT); const bf16_t* SPt = (const bf16_t*)(P.ws + WS_SP); const bf16_t* V = (const bf16_t*)(P.ws + WS_V); bf16_t* MIX = (bf16_t*)(P.ws + WS_MIX);
    const float* gates = (const float*)(P.ws + WS_SMALL) + SM_GATES;
    __syncthreads();
    for (int i = tid; i < 64 * 72; i += 512) Sp[i] = 0;
    for (int i = tid; i < 16 * 72; i += 512) { const bf16_t v = (i < 72) ? (bf16_t)0x3F80 : (bf16_t)0; vT[32 * 72 + i] = v; vTd[32 * 72 + i] = 0; }
    const int qrow = tid >> 4, qch = (tid & 15) * 8, ktrow = tid >> 3, ktch = (tid & 7) * 8, task0 = (b * 4 + h) * 32;
    f32x4 Cacc[3][2];
#pragma unroll
    for (int a = 0; a < 3; ++a)
#pragma unroll
        for (int c2 = 0; c2 < 2; ++c2) Cacc[a][c2] = (f32x4){0.f, 0.f, 0.f, 0.f};
    float m_prev = 0.f;
    LAS float* gsl = (LAS float*)(lds + 90624);
    for (int cc = w; cc < 32; cc += 8) {
        const size_t tok = (size_t)b * SEQ + cc * 64 + lane;
        const float li = gates[tok * 8 + h]; float x = gates[tok * 8 + 4 + h];
#pragma unroll
        for (int off = 1; off < 64; off <<= 1) { const float t = __shfl_up(x, off); if (lane >= off) x += t; }
        const float wv = li - x; float pm = wv;
#pragma unroll
        for (int off = 1; off < 64; off <<= 1) { const float t = __shfl_up(pm, off); if (lane >= off) pm = fmaxf(pm, t); }
        gsl[cc * 192 + lane] = wv; gsl[cc * 192 + 64 + lane] = pm; gsl[cc * 192 + 128 + lane] = x;
    }
    __syncthreads();
    u32x4 rq[2], rkt[2], rsp; u32x4 vraw = {0u, 0u, 0u, 0u};
    const int vs = (tid >> 2) & 63, vcg = tid & 3;
#define ML_PREFETCH(cc) do { const size_t tbn_ = (size_t)b * SEQ + (cc) * 64; const int task_ = task0 + (cc); \
        _Pragma("unroll") for (int i_ = 0; i_ < 2; ++i_) { rq[i_] = *(const u32x4*)(QKC + (tbn_ + qrow + 32 * i_) * 1024 + h * 128 + qch); \
            rkt[i_] = *(const u32x4*)(KT + (size_t)task_ * 8192 + (ktrow + 64 * i_) * 64 + ktch); } \
        rsp = *(const u32x4*)(SPt + (size_t)task_ * 4096 + tid * 8); \
        if (w >= 4) vraw = *(const u32x4*)(V + (tbn_ + vs) * 1024 + h * 256 + js * 32 + vcg * 8); \
        } while (0)
    ML_PREFETCH(0);
    const CvtDesc cvdflt = cvt_decode(P, CVT_EARLY);
    CvtDesc cvdA = cvdflt, cvdB = cvdflt; f32x4 cvvA[4], cvvB[4]; f32x4 cvgA, cvgB; bool pendA = false, pendB = false;
    u32x2 hold0 = {0u, 0u}, hold1 = {0u, 0u}; bf16_t* hold_dst = MIX;
    auto chunk_body = [&](const int c, CvtDesc& cvd, f32x4 (&cvv)[4], f32x4& cvg, bool& cv_pend) __attribute__((always_inline)) {
        const int t0 = c * 64; const size_t tokbase = (size_t)b * SEQ + t0;
#pragma unroll
        for (int i = 0; i < 2; ++i) { *(LAS u32x4*)(qs + (qrow + 32 * i) * 136 + qch) = rq[i]; *(LAS u32x4*)(kT + (ktrow + 64 * i) * 72 + ktch) = rkt[i]; }
        *(LAS u32x4*)(Sp + (tid >> 3) * 72 + (tid & 7) * 8) = rsp;
        const LAS float* gc = gsl + c * 192;
        const float M63 = fmaxf(m_prev, gc[127]), a63 = fexp(m_prev - M63), m_next = gc[191] + M63;
        if (w >= 4) {
            LAS bf16_t* d = vT + (vcg * 8) * 72 + vs;
            d[0] = (bf16_t)(vraw.x & 0xffff); d[72] = (bf16_t)(vraw.x >> 16); d[144] = (bf16_t)(vraw.y & 0xffff); d[216] = (bf16_t)(vraw.y >> 16);
            d[288] = (bf16_t)(vraw.z & 0xffff); d[360] = (bf16_t)(vraw.z >> 16); d[432] = (bf16_t)(vraw.w & 0xffff); d[504] = (bf16_t)(vraw.w >> 16);
            { const float d = fexp(gc[vs] - M63); LAS bf16_t* dd = vTd + (vcg * 8) * 72 + vs;
              dd[0] = f2bf(bf_lo(vraw.x) * d); dd[72] = f2bf(bf_hi(vraw.x) * d); dd[144] = f2bf(bf_lo(vraw.y) * d); dd[216] = f2bf(bf_hi(vraw.y) * d);
              dd[288] = f2bf(bf_lo(vraw.z) * d); dd[360] = f2bf(bf_hi(vraw.z) * d); dd[432] = f2bf(bf_lo(vraw.w) * d); dd[504] = f2bf(bf_hi(vraw.w) * d);
              if (vcg == 0) vTd[32 * 72 + vs] = f2bf(d); }
#pragma unroll
            for (int vt = 0; vt < 3; ++vt)
#pragma unroll
                for (int k2 = 0; k2 < 2; ++k2) { u32x2 pk; pk.x = cvt_pk_bf16(Cacc[vt][k2][0], Cacc[vt][k2][1]); pk.y = cvt_pk_bf16(Cacc[vt][k2][2], Cacc[vt][k2][3]);
                    *(LAS u32x2*)(Cb + (vt * 16 + fr) * 136 + ((w - 4) * 2 + k2) * 16 + fq * 4) = pk; }
        }
        if (cv_pend) cvt_store4(cvd, cvv, cvg);
        if (w < 4 && c > 0) { *(u32x2*)hold_dst = hold0; *(u32x2*)(hold_dst + 16) = hold1; }
        if (c + 1 < 32) ML_PREFETCH(c + 1);
        {
          const int cvt_h = c * (int)gridDim.x + (int)blockIdx.x; cv_pend = cvt_h < 2 * (CVT_TOT - CVT_EARLY);
          if (cv_pend) { cvd = cvt_decode(P, CVT_EARLY + (cvt_h >> 1)); cvd.k0 += (cvt_h & 1) * 128; } else cvd = cvdflt;
          cvt_load4(cvd, cvv, cvg); }
        LDS_BARRIER();
        f32x4 o2[3];
        if (w < 4) {
#pragma unroll
            for (int vt = 0; vt < 3; ++vt) o2[vt] = (f32x4){0.f, 0.f, 0.f, 0.f};
#pragma unroll
            for (int kk = 0; kk < 4; ++kk) { const bf16x8 bb = *(const LAS bf16x8*)(qs + (w * 16 + fr) * 136 + kk * 32 + fq * 8);
#pragma unroll
                for (int vt = 0; vt < 3; ++vt) { const bf16x8 a = *(const LAS bf16x8*)(Cb + (vt * 16 + fr) * 136 + kk * 32 + fq * 8); o2[vt] = __builtin_amdgcn_mfma_f32_16x16x32_bf16(a, bb, o2[vt], 0, 0, 0); } }
        }
        if (w < 4) {
            const int ti = w; f32x4 o1[3];
#pragma unroll
            for (int vt = 0; vt < 3; ++vt) o1[vt] = (f32x4){0.f, 0.f, 0.f, 0.f};
#pragma unroll
            for (int kk = 0; kk < 2; ++kk) { const bf16x8 bb = *(const LAS bf16x8*)(Sp + (ti * 16 + fr) * 72 + kk * 32 + fq * 8);
#pragma unroll
                for (int vt = 0; vt < 3; ++vt) { const bf16x8 a = *(const LAS bf16x8*)(vT + (vt * 16 + fr) * 72 + kk * 32 + fq * 8); o1[vt] = __builtin_amdgcn_mfma_f32_16x16x32_bf16(a, bb, o1[vt], 0, 0, 0); } }
            {
                const int tr = ti * 16 + fr; const float Mt = fmaxf(m_prev, gc[64 + tr]); const float at = fexp(m_prev - Mt), en = fexp(-(gc[128 + tr] + Mt)), ft = fexp(gc[64 + tr] - Mt);
#pragma unroll
                for (int vt = 0; vt < 3; ++vt) o1[vt] = o1[vt] * ft;
                const float dn = o1[2][0] + at * o2[2][0]; const float den = __shfl(dn, fr);
                const float inv = frcp(fmaxf(fabsf(den), en));
                hold_dst = MIX + (tokbase + tr) * 2048 + h * 256 + js * 32 + fq * 4;
                hold0.x = cvt_pk_bf16((o1[0][0] + at * o2[0][0]) * inv, (o1[0][1] + at * o2[0][1]) * inv); hold0.y = cvt_pk_bf16((o1[0][2] + at * o2[0][2]) * inv, (o1[0][3] + at * o2[0][3]) * inv);
                hold1.x = cvt_pk_bf16((o1[1][0] + at * o2[1][0]) * inv, (o1[1][1] + at * o2[1][1]) * inv); hold1.y = cvt_pk_bf16((o1[1][2] + at * o2[1][2]) * inv, (o1[1][3] + at * o2[1][3]) * inv);
            }
        } else {
#pragma unroll
            for (int vt = 0; vt < 3; ++vt)
#pragma unroll
                for (int k2 = 0; k2 < 2; ++k2) Cacc[vt][k2] = Cacc[vt][k2] * a63;
#pragma unroll
            for (int kk = 0; kk < 2; ++kk) {
                bf16x8 a[3], bb[2];
#pragma unroll
                for (int vt = 0; vt < 3; ++vt) a[vt] = *(const LAS bf16x8*)(vTd + (vt * 16 + fr) * 72 + kk * 32 + fq * 8);
#pragma unroll
                for (int k2 = 0; k2 < 2; ++k2) bb[k2] = *(const LAS bf16x8*)(kT + (((w - 4) * 2 + k2) * 16 + fr) * 72 + kk * 32 + fq * 8);
#pragma unroll
                for (int vt = 0; vt < 3; ++vt)
#pragma unroll
                    for (int k2 = 0; k2 < 2; ++k2) Cacc[vt][k2] = __builtin_amdgcn_mfma_f32_16x16x32_bf16(bb[k2], a[vt], Cacc[vt][k2], 0, 0, 0);
            }
        }
        m_prev = m_next;
        LDS_BARRIER();
        };
    for (int c2 = 0; c2 < 16; ++c2) { chunk_body(2 * c2, cvdA, cvvA, cvgA, pendA); chunk_body(2 * c2 + 1, cvdB, cvvB, cvgB, pendB); }
    if (pendA) cvt_store4(cvdA, cvvA, cvgA);
    if (pendB) cvt_store4(cvdB, cvvB, cvgB);
    if (w < 4) { *(u32x2*)hold_dst = hold0; *(u32x2*)(hold_dst + 16) = hold1; }
#undef ML_PREFETCH
}

__device__ void phase_hm_finalize(const Params& P) {
    bf16_t* MIX = (bf16_t*)(P.ws + WS_MIX); const bf16_t* O = (const bf16_t*)(P.ws + WS_O);
    const float* gn = P.in[I_MLN];
    for (size_t i = (size_t)blockIdx.x * 512 + threadIdx.x; i < (size_t)T_TOK * 128; i += (size_t)gridDim.x * 512) {
        const size_t t = i >> 7; const int c = (int)(i & 127) * 8;
        const u32x4 hv = *(const u32x4*)(MIX + t * 2048 + c), ov = *(const u32x4*)(O + t * 1024 + c);
        const f32x4 g0 = *(const f32x4*)(gn + c), g1 = *(const f32x4*)(gn + c + 4);
        const float h0 = bf_lo(hv.x), h1 = bf_hi(hv.x), h2 = bf_lo(hv.y), h3 = bf_hi(hv.y), h4 = bf_lo(hv.z), h5 = bf_hi(hv.z), h6 = bf_lo(hv.w), h7 = bf_hi(hv.w);
        float ss = h0 * h0 + h1 * h1 + h2 * h2 + h3 * h3 + h4 * h4 + h5 * h5 + h6 * h6 + h7 * h7;
        ss += __shfl_xor(ss, 1); ss += __shfl_xor(ss, 2); ss += __shfl_xor(ss, 4); ss += __shfl_xor(ss, 8); ss += __shfl_xor(ss, 16);
        const float rs = rs_of(ss, 1.0f / 256.0f);
        u32x4 w;
        w.x = cvt_pk_bf16(h0 * rs * g0[0] * bf_lo(ov.x), h1 * rs * g0[1] * bf_hi(ov.x));
        w.y = cvt_pk_bf16(h2 * rs * g0[2] * bf_lo(ov.y), h3 * rs * g0[3] * bf_hi(ov.y));
        w.z = cvt_pk_bf16(h4 * rs * g1[0] * bf_lo(ov.z), h5 * rs * g1[1] * bf_hi(ov.z));
        w.w = cvt_pk_bf16(h6 * rs * g1[2] * bf_lo(ov.w), h7 * rs * g1[3] * bf_hi(ov.w));
        *(u32x4*)(MIX + t * 2048 + c) = w;
    }
}
__device__ void phase_final_norm(const Params& P) {
    const float* ssq = (const float*)(P.ws + WS_SMALL) + SM_SSQ3; const float* gn = P.in[I_FINN]; const bf16_t* XBp = (const bf16_t*)(P.ws + WS_XB);
#pragma unroll 2
    for (size_t i = (size_t)blockIdx.x * 512 + threadIdx.x; i < (size_t)T_TOK * 256; i += (size_t)gridDim.x * 512) {
        const size_t t = i >> 8; const int c = (int)(i & 255) * 8;
        const float rs = rs_of(ssq[t], 1.0f / DM);
        const u32x4 xv = *(const u32x4*)(XBp + t * DM + c); const f32x4 g0 = *(const f32x4*)(gn + c), g1 = *(const f32x4*)(gn + c + 4);
        const f32x4 o0 = {bf_lo(xv.x) * rs * g0[0], bf_hi(xv.x) * rs * g0[1], bf_lo(xv.y) * rs * g0[2], bf_hi(xv.y) * rs * g0[3]};
        const f32x4 o1 = {bf_lo(xv.z) * rs * g1[0], bf_hi(xv.z) * rs * g1[1], bf_lo(xv.w) * rs * g1[2], bf_hi(xv.w) * rs * g1[3]};
        __builtin_nontemporal_store(o0, (f32x4*)(P.out + t * DM + c)); __builtin_nontemporal_store(o1, (f32x4*)(P.out + t * DM + c + 4));
    }
}

struct EpiE { float* E; __device__ __forceinline__ void operator()(int r, int c, const f32x4& v) const { *(f32x4*)(E + (size_t)r * 128 + c) = v; } };
struct EpiY { bf16_t* YS; int g, nt; __device__ __forceinline__ void operator()(int r, int c, const f32x4& v) const {
    const int n = nt * 128 + c, t = n >> 4, h = n & 15; u32x2 w; w.x = cvt_pk_bf16(gelu_tanh(v[0]), gelu_tanh(v[1])); w.y = cvt_pk_bf16(gelu_tanh(v[2]), gelu_tanh(v[3]));
    *(u32x2*)(YS + ((size_t)r * 16 + t) * 1024 + g * 16 + h) = w; } };

#define PROBE 0
#define DUP_P1 0
#define DUP_MLSTM 0
#define PROBE_AMASK 0xFFF
#define PROBE_BMASK 0x001
#if PROBE
#define TS(i) do { if (blockIdx.x == 0 && threadIdx.x == 0) ((unsigned long long*)(P.ws + WS_SMALL) + SM_ENDF)[i] = __builtin_amdgcn_s_memrealtime(); } while (0)
#else
#define TS(i) do { } while (0)
#endif
#define XB_TMO      128
#define XB_XCNT(j)  (256  + 64 * (j))
#define XB_XSUB(j)  (1280 + 64 * (j))
#define XB_XGEN(j)  (2304 + 64 * (j))
#define XB_TOP      3328
#define XB_TOPGEN   3392
#define XCD_BAR_WORDS 3456
#define XB_SPIN_CAP (1u << 18)

__device__ __forceinline__ unsigned xb_ld(unsigned* p)              { return __hip_atomic_load(p, __ATOMIC_RELAXED, __HIP_MEMORY_SCOPE_AGENT); }
__device__ __forceinline__ unsigned xb_add(unsigned* p, unsigned v) { return __hip_atomic_fetch_add(p, v, __ATOMIC_RELAXED, __HIP_MEMORY_SCOPE_AGENT); }
__device__ __forceinline__ unsigned xb_xcc_id() { return (unsigned)__builtin_amdgcn_s_getreg((3 << 11) | 20) & 0xFu; }
#define XB_SPIN(cond, bar) do { unsigned _sp = 0; while (cond) { __builtin_amdgcn_s_sleep(1); \
    if ((++_sp & 255u) == 0u) { if (xb_ld(&(bar)[XB_TMO])) break; if (_sp > XB_SPIN_CAP) { atomicAdd(&(bar)[XB_TMO], 1u); break; } } } } while (0)

struct XcdBarrier {
    unsigned* bar; unsigned x;
    volatile LAS unsigned* st;
};

__device__ __forceinline__ XcdBarrier xcd_barrier_post(unsigned* bar, volatile LAS unsigned* st) {
    XcdBarrier b; b.bar = bar; b.x = xb_xcc_id(); b.st = st;
    if (threadIdx.x == 0) (void)xb_add(&bar[XB_XCNT(b.x)], 1u);
    return b;
}
__device__ __forceinline__ void xcd_barrier_complete(unsigned* bar, unsigned x, unsigned& nloc, unsigned& nx) {
    const unsigned G = gridDim.x * gridDim.y * gridDim.z;
    unsigned sum, cnt, mine, sp = 0u;
    for (;;) {
        sum = 0u; cnt = 0u; mine = 0u;
#pragma unroll
        for (unsigned j = 0; j < 16; ++j) { const unsigned c = xb_ld(&bar[XB_XCNT(j)]); sum += c; cnt += (c > 0u) ? 1u : 0u; mine = (j == x) ? c : mine; }
        if (sum == G) break;
        __builtin_amdgcn_s_sleep(1);
        if ((++sp & 255u) == 0u) { if (xb_ld(&bar[XB_TMO])) break; if (sp > XB_SPIN_CAP) { atomicAdd(&bar[XB_TMO], 1u); break; } }
    }
    nloc = mine > 0u ? mine : 1u; nx = cnt > 0u ? cnt : 1u;
}

__device__ __forceinline__ void xcd_barrier(const XcdBarrier& b) {
    asm volatile("s_waitcnt vmcnt(0)" ::: "memory");
    __syncthreads();
    if (threadIdx.x == 0) {
        unsigned* bar = b.bar;
        __builtin_amdgcn_s_waitcnt(0);
        unsigned nloc = b.st[0], nx = b.st[1];
        if (nloc == 0u) { xcd_barrier_complete(bar, b.x, nloc, nx); b.st[0] = nloc; b.st[1] = nx; }
        const unsigned old = xb_add(&bar[XB_XSUB(b.x)], 1u);
        const unsigned gen = old / nloc;
        if (old + 1u == (gen + 1u) * nloc) {
            __builtin_amdgcn_fence(__ATOMIC_RELEASE, "agent");
            asm volatile("s_waitcnt vmcnt(0)" ::: "memory");
            const unsigned og = xb_add(&bar[XB_TOP], 1u);
            const unsigned tg = og / nx;
            if (og + 1u == (tg + 1u) * nx) xb_add(&bar[XB_TOPGEN], 1u);
            else XB_SPIN(xb_ld(&bar[XB_TOPGEN]) == tg, bar);
            __builtin_amdgcn_fence(__ATOMIC_ACQUIRE, "agent");
            xb_add(&bar[XB_XGEN(b.x)], 1u);
            asm volatile("s_waitcnt vmcnt(0)" ::: "memory");
        } else {
            XB_SPIN(xb_ld(&bar[XB_XGEN(b.x)]) == gen, bar);
            __builtin_amdgcn_fence(__ATOMIC_ACQUIRE, "agent");
            asm volatile("s_waitcnt vmcnt(0)" ::: "memory");
        }
    }
    __syncthreads();
}


#define GRID_SYNC_CG() do { asm volatile("s_waitcnt vmcnt(0) lgkmcnt(0)" ::: "memory"); grid.sync(); } while (0)
#define GRID_SYNC() xcd_barrier(xb)
__global__ void __launch_bounds__(512, 2) fwd_megakernel(Params P) {
    extern __shared__ __attribute__((aligned(16))) unsigned char shm_raw[];
    LAS unsigned char* lds = (LAS unsigned char*)shm_raw;
    cg::grid_group grid = cg::this_grid();
    float* sm = (float*)(P.ws + WS_SMALL);
    bf16_t* XB = (bf16_t*)(P.ws + WS_XB); bf16_t* G = (bf16_t*)(P.ws + WS_G); bf16_t* MIX = (bf16_t*)(P.ws + WS_MIX);
    pg8::StaticOrder S;
    volatile LAS unsigned* xst = (volatile LAS unsigned*)(lds + 131072);
    if (threadIdx.x < 2) xst[threadIdx.x] = 0u;
    __syncthreads();
    const XcdBarrier xb = xcd_barrier_post((unsigned*)(P.ws + WS_BAR), xst);
    TS(0);
    phase_prep(P, lds);
    if (P.out == nullptr) GRID_SYNC_CG();
    GRID_SYNC(); TS(1);
    { pg8::Gemm g{XB, (const bf16_t*)(P.ws + WS_W13_1), T_TOK, 2 * DFF, DM, DM, DM}; S.init(g.M, g.N, gridDim.x, blockIdx.x);
      EpiSwiGLU e{G, sm + SM_SSQ0, P.in[I_F1W2], P.in[I_WIN], P.in[I_MIXN], P.ws}; pg8::gemm_phase(lds, g, S, e);
#if DUP_P1
      __syncthreads(); pg8::gemm_phase(lds, g, S, e);
#endif
    }
    GRID_SYNC(); TS(2);
    { pg8::Gemm g{G, (const bf16_t*)(P.ws + WS_W2_1), T_TOK, DM, DFF, DFF, DFF}; S.init(g.M, g.N, gridDim.x, blockIdx.x);
      EpiResid<true> e{nullptr, XB, sm + SM_SSQ1, 0.5f}; pg8::gemm_phase(lds, g, S, e); }
    GRID_SYNC(); TS(3);
    { pg8::Gemm g{XB, (const bf16_t*)(P.ws + WS_WIN), T_TOK, 4096, DM, DM, DM}; S.init(g.M, g.N, gridDim.x, blockIdx.x);
      EpiWin e{(bf16_t*)(P.ws + WS_QK), (bf16_t*)(P.ws + WS_V), (bf16_t*)(P.ws + WS_O), (bf16_t*)(P.ws + WS_UX), sm + SM_SSQ1}; pg8::gemm_phase(lds, g, S, e); }
    phase_gates(P, lds);
    GRID_SYNC(); TS(4);
    phase_mix_pre(P, lds);
    __syncthreads();
    for (int id = blockIdx.x; id < 512; id += gridDim.x) { const int g = id >> 3, mt = id & 7;
        EpiE e{(float*)(P.ws + WS_E) + ((size_t)g * 1024 + mt * 128) * 128};
        sgemm_unit(lds, (const bf16_t*)(P.ws + WS_UX) + ((size_t)g * 1024 + mt * 128) * 384, 384, (const bf16_t*)(P.ws + WS_BTE) + (size_t)g * 128 * 256, 256, 256, e); }
    GRID_SYNC(); TS(5);
    phase_s5_scan(P);
    for (int it = blockIdx.x; it < 256; it += gridDim.x) mlstm_item(P, lds, it, sm + SM_SSQH);
#if DUP_MLSTM
    phase_s5_scan(P);
    for (int it = blockIdx.x; it < 256; it += gridDim.x) mlstm_item(P, lds, it, sm + SM_ENDF + 1024);
#endif
    GRID_SYNC(); TS(6);
    for (int id = blockIdx.x; id < 1024; id += gridDim.x) { const int g = id >> 4, mt = (id >> 1) & 7, nt = id & 1;
        EpiY e{(bf16_t*)(P.ws + WS_YS) + (size_t)(mt * 128) * 16 * 1024, g, nt};
        sgemm_unit(lds, (const bf16_t*)(P.ws + WS_UX) + ((size_t)g * 1024 + mt * 128) * 384, 384, (const bf16_t*)(P.ws + WS_BTC) + ((size_t)g * 256 + nt * 128) * 384, 384, 384, e); }
    phase_hm_finalize(P);
    GRID_SYNC(); TS(7);
    { pg8::Gemm g{(const bf16_t*)(P.ws + WS_YS), (const bf16_t*)(P.ws + WS_WGLU), T_TOK, 1024, 1024, 1024, 1024}; S.init(g.M, g.N, gridDim.x, blockIdx.x);
      EpiGLU e{(const bf16_t*)(P.ws + WS_YS), MIX, P.in[I_BGLU]}; pg8::gemm_phase(lds, g, S, e); }
    GRID_SYNC(); TS(8);
    { pg8::Gemm g{MIX, (const bf16_t*)(P.ws + WS_WOUT), T_TOK, DM, DM, DM, DM}; S.init(g.M, g.N, gridDim.x, blockIdx.x);
      EpiResid<true> e{nullptr, XB, sm + SM_SSQ2, 1.0f}; pg8::gemm_phase(lds, g, S, e); }
    GRID_SYNC(); TS(9);
    { pg8::Gemm g{XB, (const bf16_t*)(P.ws + WS_W13_2), T_TOK, 2 * DFF, DM, DM, DM}; S.init(g.M, g.N, gridDim.x, blockIdx.x);
      EpiSwiGLU e{G, sm + SM_SSQ2, nullptr, nullptr, nullptr, nullptr}; pg8::gemm_phase(lds, g, S, e); }
    GRID_SYNC(); TS(10);
    { pg8::Gemm g{G, (const bf16_t*)(P.ws + WS_W2_2), T_TOK, DM, DFF, DFF, DFF}; S.init(g.M, g.N, gridDim.x, blockIdx.x);
      EpiResid<true> e{nullptr, XB, sm + SM_SSQ3, 0.5f}; pg8::gemm_phase(lds, g, S, e); }
    GRID_SYNC(); TS(11);
    phase_final_norm(P);
#if PROBE
    GRID_SYNC(); TS(12);
    if (blockIdx.x == 0 && threadIdx.x == 0) {
        float sa = 0.f, sb = 0.f; const unsigned long long* tsv = (const unsigned long long*)(P.ws + WS_SMALL) + SM_ENDF;
        const int amask = PROBE_AMASK, bmask = PROBE_BMASK;
#pragma unroll
        for (int i = 0; i < 12; ++i) { const float d = (float)(tsv[i + 1] - tsv[i]) * 0.01f; if ((amask >> i) & 1) sa += d; if ((bmask >> i) & 1) sb += d; }
        P.out[0] += sa; for (int i = 1; i <= 100; ++i) P.out[i] += sb;
    }
#endif
}

extern "C" void kernel_launch(void* const* d_in, const int* in_sizes, int n_in, void* d_out, int out_size, void* d_ws, size_t ws_size, hipStream_t stream) {
    static int grid = 0;
    if (grid == 0) {
        if (n_in != 28 || ws_size < WS_END) { fprintf(stderr, "kernel_launch: unexpected n_in %d / ws_size %zu (need %zu)\n", n_in, ws_size, (size_t)WS_END); grid = -1; return; }
        int dev = 0, cus = 0, per_cu = 0;
        hipGetDevice(&dev); hipDeviceGetAttribute(&cus, hipDeviceAttributeMultiprocessorCount, dev);
        if (hipFuncSetAttribute((const void*)fwd_megakernel, hipFuncAttributeMaxDynamicSharedMemorySize, LDS_BYTES) != hipSuccess) { fprintf(stderr, "kernel_launch: hipFuncSetAttribute failed\n"); grid = -1; return; }
        if (hipOccupancyMaxActiveBlocksPerMultiprocessor(&per_cu, (const void*)fwd_megakernel, 512, LDS_BYTES) != hipSuccess || per_cu < 1) { fprintf(stderr, "kernel_launch: occupancy query gave %d\n", per_cu); per_cu = 1; }
        (void)hipGetLastError();
        grid = cus;
        if (grid > 256) grid = 256;
    }
    if (grid < 0) return;
    Params p{};
    for (int i = 0; i < 28; ++i) p.in[i] = (const float*)d_in[i];
    p.out = (float*)d_out; p.ws = (unsigned char*)d_ws;
    if (hipMemsetAsync((char*)d_ws + WS_BAR, 0, XCD_BAR_WORDS * sizeof(unsigned), stream) != hipSuccess) { fprintf(stderr, "kernel_launch: memset of barrier words failed\n"); return; }
    void* args[] = {&p};
    hipError_t e = hipLaunchCooperativeKernel((const void*)fwd_megakernel, dim3(grid), dim3(512), args, LDS_BYTES, stream);
    if (e != hipSuccess) fprintf(stderr, "cooperative launch failed: %s (grid %d)\n", hipGetErrorString(e), grid);
}
```

```cpp
#include <hip/hip_runtime.h>
#include <hip/hip_cooperative_groups.h>
#include <cstdio>
namespace cg = cooperative_groups;

#define LAS __attribute__((address_space(3)))
typedef unsigned short bf16_t;
typedef short bf16x8 __attribute__((ext_vector_type(8)));
typedef float f32x4 __attribute__((ext_vector_type(4)));
typedef float f32x2 __attribute__((ext_vector_type(2)));
typedef unsigned u32x4 __attribute__((ext_vector_type(4)));
typedef unsigned u32x2 __attribute__((ext_vector_type(2)));

constexpr int T_TOK = 16384, DM = 2048, DFF = 5632, SEQ = 2048;
constexpr int INC = 4104;
constexpr float EPS = 1e-6f;
constexpr int LDS_BYTES = 131072 + 64;
constexpr size_t MiB = 1024 * 1024;
constexpr size_t WS_W13_1 = 0, WS_W2_1 = 44 * MiB, WS_W13_2 = 66 * MiB, WS_W2_2 = 110 * MiB, WS_WIN = 132 * MiB, WS_WOUT = 148 * MiB,
                 WS_WGLU = 156 * MiB, WS_BTC = 158 * MiB, WS_BTE = 170 * MiB, WS_WG = 174 * MiB, WS_SMALL = 175 * MiB, WS_BAR = 177 * MiB,
                 WS_XB = 178 * MiB, WS_G = 242 * MiB, WS_MIX = 418 * MiB, WS_QKC = WS_W13_1  , WS_KT = 32 * MiB, WS_SP = 48 * MiB, WS_END = 482 * MiB;
constexpr size_t WS_QK = WS_G, WS_V = WS_G + 32 * MiB, WS_O = WS_G + 64 * MiB, WS_UX = WS_G + 96 * MiB, WS_E = WS_G + 144 * MiB, WS_YS = WS_QK;
constexpr size_t SM_SSQ0 = 0, SM_SSQ1 = 16384, SM_SSQ2 = 32768, SM_SSQ3 = 49152, SM_SSQH = 65536, SM_GATES = 131072, SM_LAML = 262144, SM_GS = 262144 + 8192, SM_ENDF = 262144 + 8192 + 196608;

struct Params { const float* in[28]; float* out; unsigned char* ws; };
enum { I_X = 0, I_F1N, I_F1W1, I_F1W3, I_F1W2, I_MIXN, I_WIN, I_CONVW, I_CONVB, I_BI, I_BF, I_MLN, I_LRE, I_LIM, I_LDT, I_BRE, I_BIM, I_CRE, I_CIM, I_DSK,
       I_WGLU, I_BGLU, I_WOUT, I_F2N, I_F2W1, I_F2W3, I_F2W2, I_FINN };

__device__ __forceinline__ unsigned cvt_pk_bf16(float lo, float hi) { unsigned r; asm volatile("v_cvt_pk_bf16_f32 %0, %1, %2" : "=v"(r) : "v"(lo), "v"(hi)); return r; }
__device__ __forceinline__ float bf_lo(unsigned u) { return __uint_as_float(u << 16); }
__device__ __forceinline__ float bf_hi(unsigned u) { return __uint_as_float(u & 0xffff0000u); }
__device__ __forceinline__ float bf2f(bf16_t b) { return __uint_as_float(((unsigned)b) << 16); }
__device__ __forceinline__ bf16_t f2bf(float f) { return (bf16_t)(cvt_pk_bf16(f, 0.f) & 0xffffu); }
__device__ __forceinline__ float frcp(float x) { return __builtin_amdgcn_rcpf(x); }
__device__ __forceinline__ float fexp(float x) { return __builtin_amdgcn_exp2f(x * 1.4426950408889634f); }
__device__ __forceinline__ float sigmoidf_(float x) { return frcp(1.0f + fexp(-x)); }
__device__ __forceinline__ float siluf_(float x) { return x * frcp(1.0f + fexp(-x)); }
__device__ __forceinline__ float gelu_tanh(float x) { const float u = 0.7978845608f * (x + 0.044715f * x * x * x); return x * frcp(1.0f + fexp(-2.0f * u)); }
__device__ __forceinline__ float rs_of(float ssq, float inv_n) { return rsqrtf(ssq * inv_n + EPS); }

#define LDS_BARRIER() do { asm volatile("s_waitcnt lgkmcnt(0)" ::: "memory"); __builtin_amdgcn_s_barrier(); asm volatile("" ::: "memory"); } while (0)
namespace pg8 {
constexpr int BM = 256, BK = 64, HALF = 128, HTB = HALF * BK * 2, NXCD = 8, WGM = 8;
__host__ __device__ __forceinline__ int lds_byte(int r, int c) { const int st = (r >> 4) * 2 + (c >> 5), rr = r & 15, cc = c & 31, ob = rr * 64 + cc * 2; return st * 1024 + (ob ^ (((ob >> 9) & 1) << 5)); }
__host__ __device__ __forceinline__ void stage_rc(int b, int& R, int& C) { const int st = b / 1024, sb = b % 1024, swz = sb ^ (((sb >> 9) & 1) << 5); R = (st >> 1) * 16 + swz / 64; C = (st & 1) * 32 + (swz % 64) / 2; }
__host__ __device__ __forceinline__ int perm32(int rho) { const int n = rho >> 4, i = rho & 15; return 8 * (i >> 2) + 4 * n + (i & 3); }
struct Unit { int pm, pn; };
struct Gemm { const bf16_t* A; const bf16_t* Bt; int M, N, K, lda, ldb; };
struct StaticOrder {
    int nM, nN, nwg, G, c;
    __device__ void init(int M, int N, int G_, int c_) { nM = M / BM; nN = N / BM; nwg = nM * nN; G = G_; c = c_; }
    __device__ bool next(int i, Unit& u) const {
        const long L = (long)i * G + c; if (L >= nwg) return false;
        int wgid = (int)L; { const int q = nwg / NXCD, r = nwg % NXCD, xcd = wgid % NXCD, off = wgid / NXCD; wgid = (xcd < r ? xcd * (q + 1) : r * (q + 1) + (xcd - r) * q) + off; }
        const int nig = WGM * nN, gid = wgid / nig, fm = gid * WGM, gsz = (nM - fm) < WGM ? (nM - fm) : WGM;
        u.pm = fm + ((wgid % nig) % gsz); u.pn = (wgid % nig) / gsz; return true;
    }
};
template <class Epi>
__device__ __forceinline__ void gemm_phase(LAS unsigned char* lds, const Gemm g, const StaticOrder& S, const Epi& E) {
    int tid = threadIdx.x; asm volatile("" : "+v"(tid));
    const int wid = __builtin_amdgcn_readfirstlane(tid >> 6), lane = tid & 63, wr = wid >> 2, wc = wid & 3, fr = lane & 15, fq = lane >> 4;
    const int K = g.K, nt = K / BK;
    unsigned voffA[2], voffB[2];
#pragma unroll
    for (int i = 0; i < 2; ++i) { int R, C; stage_rc(tid * 16 + i * 8192, R, C); const int Rb = (R & ~31) + perm32(R & 31);
        voffA[i] = (unsigned)(R * g.lda + C) * 2u; voffB[i] = (unsigned)(Rb * g.ldb + C) * 2u; }
    const size_t kstep = (size_t)(BK * 2);
    const size_t hstepA = (size_t)HALF * g.lda * 2, hstepB = (size_t)HALF * g.ldb * 2;
    const size_t tstepA = 2 * hstepA, tstepB = 2 * hstepB;
    const unsigned ldsw = (unsigned)wid * 1024u;
    const int aoff = lds_byte(wr * 64 + fr, fq * 8), boff = lds_byte(wc * 32 + fr, fq * 8);
#define PG8_SA(b, h) (((b) * 2 + (h)) * HTB)
#define PG8_SB(b, h) ((4 + (b) * 2 + (h)) * HTB)
#define PG8_STAGE(bufoff, gbase, voff) do { _Pragma("unroll") for (int _i = 0; _i < 2; ++_i) \
        __builtin_amdgcn_global_load_lds((const unsigned*)((const char*)(gbase) + (voff)[_i]), (LAS unsigned*)(lds + (bufoff) + ldsw + _i * 8192), 16, 0, 0); } while (0)
#define PG8_LDA(dst, b, h) do { _Pragma("unroll") for (int m = 0; m < 4; ++m) _Pragma("unroll") for (int k = 0; k < 2; ++k) dst[m][k] = *(const LAS bf16x8*)(lds + PG8_SA(b, h) + aoff + m * 2048 + k * 1024); } while (0)
#define PG8_LDB(dst, b, h) do { _Pragma("unroll") for (int n = 0; n < 2; ++n) _Pragma("unroll") for (int k = 0; k < 2; ++k) dst[n][k] = *(const LAS bf16x8*)(lds + PG8_SB(b, h) + boff + n * 2048 + k * 1024); } while (0)
#define PG8_MMA(ai, bj, At, Bt) do { __builtin_amdgcn_s_setprio(1); _Pragma("unroll") for (int m = 0; m < 4; ++m) _Pragma("unroll") for (int n = 0; n < 2; ++n) _Pragma("unroll") for (int k = 0; k < 2; ++k) \
        acc[ai][bj][m][n] = __builtin_amdgcn_mfma_f32_16x16x32_bf16(Bt[n][k], At[m][k], acc[ai][bj][m][n], 0, 0, 0); __builtin_amdgcn_s_setprio(0); } while (0)
#define PG8_WAIT_V(n) asm volatile("s_waitcnt vmcnt(" #n ")" ::: "memory")
#define PG8_WAIT_L(n) asm volatile("s_waitcnt lgkmcnt(" #n ")" ::: "memory")
#define PG8_BAR __builtin_amdgcn_s_barrier()
#define PG8_SCHED __builtin_amdgcn_sched_barrier(0)
    Unit cur, nxt; int ui = 0;
    if (!S.next(0, cur)) return;
    f32x4 acc[2][2][4][2];
#pragma unroll
    for (int a = 0; a < 2; ++a)
#pragma unroll
        for (int b = 0; b < 2; ++b)
#pragma unroll
            for (int m = 0; m < 4; ++m)
#pragma unroll
                for (int n = 0; n < 2; ++n) acc[a][b][m][n] = (f32x4){0.f, 0.f, 0.f, 0.f};
    bf16x8 At[4][2], B0[2][2], B1[2][2];
    const char* cA = (const char*)g.A + (size_t)cur.pm * tstepA; const char* cB = (const char*)g.Bt + (size_t)cur.pn * tstepB;
    PG8_STAGE(PG8_SB(0, 0), cB, voffB); PG8_STAGE(PG8_SA(0, 0), cA, voffA); PG8_STAGE(PG8_SB(0, 1), cB + hstepB, voffB); PG8_STAGE(PG8_SA(0, 1), cA + hstepA, voffA);
    if (wr == 1) PG8_BAR;
    PG8_WAIT_V(4); PG8_BAR;
    PG8_STAGE(PG8_SB(1, 0), cB + kstep, voffB); PG8_STAGE(PG8_SA(1, 0), cA + kstep, voffA); PG8_STAGE(PG8_SB(1, 1), cB + hstepB + kstep, voffB);
    PG8_WAIT_V(6); PG8_BAR;
    for (;;) {
        const bool has_next = S.next(ui + 1, nxt);
        const char* nA = has_next ? (const char*)g.A + (size_t)nxt.pm * tstepA : cA; const char* nB = has_next ? (const char*)g.Bt + (size_t)nxt.pn * tstepB : cB;
        for (int t = 0; t < nt; t += 2) {
            const bool last = (t == nt - 2);
            const char* a1 = cA + (size_t)(t + 1) * kstep;
            const char* a2 = last ? nA : cA + (size_t)(t + 2) * kstep; const char* b2 = last ? nB : cB + (size_t)(t + 2) * kstep;
            const char* a3 = a2 + kstep; const char* b3 = b2 + kstep;
            PG8_LDB(B0, 0, 0); PG8_SCHED; PG8_LDA(At, 0, 0); PG8_STAGE(PG8_SA(1, 1), a1 + hstepA, voffA);
            PG8_WAIT_L(8); PG8_BAR; PG8_WAIT_L(0); PG8_MMA(0, 0, At, B0); PG8_BAR; PG8_SCHED;
            PG8_LDB(B1, 0, 1); PG8_STAGE(PG8_SB(0, 0), b2, voffB);
            PG8_BAR; PG8_WAIT_L(0); PG8_MMA(0, 1, At, B1); PG8_BAR;
            PG8_LDA(At, 0, 1); PG8_STAGE(PG8_SA(0, 0), a2, voffA);
            PG8_BAR; PG8_WAIT_L(0); PG8_MMA(1, 0, At, B0); PG8_BAR; PG8_SCHED;
            PG8_STAGE(PG8_SB(0, 1), b2 + hstepB, voffB);
            PG8_WAIT_V(6); PG8_BAR; PG8_MMA(1, 1, At, B1); PG8_BAR;
            PG8_LDB(B0, 1, 0); PG8_SCHED; PG8_LDA(At, 1, 0); PG8_STAGE(PG8_SA(0, 1), a2 + hstepA, voffA);
            PG8_WAIT_L(8); PG8_BAR; PG8_WAIT_L(0); PG8_MMA(0, 0, At, B0); PG8_BAR; PG8_SCHED;
            PG8_LDB(B1, 1, 1); PG8_STAGE(PG8_SB(1, 0), b3, voffB);
            PG8_BAR; PG8_WAIT_L(0); PG8_MMA(0, 1, At, B1); PG8_BAR;
            PG8_LDA(At, 1, 1); PG8_STAGE(PG8_SA(1, 0), a3, voffA);
            PG8_BAR; PG8_WAIT_L(0); PG8_MMA(1, 0, At, B0); PG8_BAR; PG8_SCHED;
            PG8_STAGE(PG8_SB(1, 1), b3 + hstepB, voffB);
            PG8_WAIT_V(6); PG8_BAR; PG8_MMA(1, 1, At, B1); PG8_BAR;
        }
        { int t2 = threadIdx.x; asm volatile("" : "+v"(t2)); const int w2 = __builtin_amdgcn_readfirstlane(t2 >> 6), l2 = t2 & 63; E(acc, cur, w2 >> 2, w2 & 3, l2 & 15, l2 >> 4); }
        if (!has_next) break;
#pragma unroll
        for (int a = 0; a < 2; ++a)
#pragma unroll
            for (int b = 0; b < 2; ++b)
#pragma unroll
                for (int m = 0; m < 4; ++m)
#pragma unroll
                    for (int n = 0; n < 2; ++n) acc[a][b][m][n] = (f32x4){0.f, 0.f, 0.f, 0.f};
        cur = nxt; cA = nA; cB = nB; ++ui;
    }
    PG8_WAIT_V(0);
    if (wr == 0) PG8_BAR;
    PG8_BAR;
#undef PG8_SA
#undef PG8_SB
#undef PG8_STAGE
#undef PG8_LDA
#undef PG8_LDB
#undef PG8_MMA
#undef PG8_WAIT_V
#undef PG8_WAIT_L
#undef PG8_BAR
#undef PG8_SCHED
}
}
using pg8::Unit;
typedef const f32x4 (&AccRef)[2][2][4][2];

struct CvtDesc { const float* src; const float* gain; bf16_t* dst; int ldsrc, col0, k0, lddst, nrow0; };
__device__ __forceinline__ void cvt_load(const CvtDesc& d, f32x4 (&v)[8], float (&g)[8]) {
    const int tid = threadIdx.x, r8 = tid >> 4, c4 = (tid & 15) * 4;
#pragma unroll
    for (int i = 0; i < 8; ++i) v[i] = *(const f32x4*)(d.src + (size_t)(d.k0 + r8 * 8 + i) * d.ldsrc + d.col0 + c4);
    if (d.gain) { const f32x4 g0 = *(const f32x4*)(d.gain + d.k0 + r8 * 8), g1 = *(const f32x4*)(d.gain + d.k0 + r8 * 8 + 4);
        g[0] = g0[0]; g[1] = g0[1]; g[2] = g0[2]; g[3] = g0[3]; g[4] = g1[0]; g[5] = g1[1]; g[6] = g1[2]; g[7] = g1[3]; }
    else {
#pragma unroll
        for (int i = 0; i < 8; ++i) g[i] = 1.0f; }
}
__device__ __forceinline__ void cvt_load4(const CvtDesc& d, f32x4 (&v)[4], f32x4& g) {
    const int tid = threadIdx.x, r4 = tid >> 4, c4 = (tid & 15) * 4;
#pragma unroll
    for (int i = 0; i < 4; ++i) v[i] = *(const f32x4*)(d.src + (size_t)(d.k0 + r4 * 4 + i) * d.ldsrc + d.col0 + c4);
    g = d.gain ? *(const f32x4*)(d.gain + d.k0 + r4 * 4) : (f32x4){1.f, 1.f, 1.f, 1.f};
}
__device__ __forceinline__ void cvt_store4(const CvtDesc& d, const f32x4 (&v)[4], const f32x4& g) {
    const int tid = threadIdx.x, r4 = tid >> 4, c4 = (tid & 15) * 4;
#pragma unroll
    for (int j = 0; j < 4; ++j) {
        u32x2 w; w.x = cvt_pk_bf16(v[0][j] * g[0], v[1][j] * g[1]); w.y = cvt_pk_bf16(v[2][j] * g[2], v[3][j] * g[3]);
        *(u32x2*)(d.dst + (size_t)(d.nrow0 + c4 + j) * d.lddst + d.k0 + r4 * 4) = w;
    }
}
__device__ __forceinline__ void cvt_store(const CvtDesc& d, const f32x4 (&v)[8], const float (&g)[8]) {
    const int tid = threadIdx.x, r8 = tid >> 4, c4 = (tid & 15) * 4;
#pragma unroll
    for (int j = 0; j < 4; ++j) {
        u32x4 w; w.x = cvt_pk_bf16(v[0][j] * g[0], v[1][j] * g[1]); w.y = cvt_pk_bf16(v[2][j] * g[2], v[3][j] * g[3]); w.z = cvt_pk_bf16(v[4][j] * g[4], v[5][j] * g[5]); w.w = cvt_pk_bf16(v[6][j] * g[6], v[7][j] * g[7]);
        *(u32x4*)(d.dst + (size_t)(d.nrow0 + c4 + j) * d.lddst + d.k0 + r8 * 8) = w;
    }
}
constexpr int CVT_T_W13 = 176 * 8, CVT_T_W2 = 32 * 22, CVT_T_WIN = 64 * 8, CVT_T_WOUT = 32 * 8, CVT_T_WGLU = 16 * 4;
constexpr int CVT_EARLY = CVT_T_W13 + CVT_T_W2 + CVT_T_WIN, CVT_TOT = CVT_EARLY + CVT_T_W13 + CVT_T_W2 + CVT_T_WOUT + CVT_T_WGLU;
__device__ __forceinline__ CvtDesc cvt_decode(const Params& P, int t) {
    CvtDesc d; int i = t; int f = 0;
    if (i >= CVT_EARLY) { i -= CVT_EARLY; f = 1; }
    if (i < CVT_T_W13) { const int nt = i >> 3, kt = i & 7; const int np = nt * 64, pn = np >> 8, bj = (np >> 7) & 1, ii = np & 127;
        { const float* a1 = f ? P.in[I_F2W1] : P.in[I_F1W1]; const float* a3 = f ? P.in[I_F2W3] : P.in[I_F1W3]; d.src = bj ? a3 : a1; } d.ldsrc = DFF; d.col0 = pn * 128 + ii; d.k0 = kt * 256; d.gain = f ? P.in[I_F2N] : P.in[I_F1N];
        d.dst = (bf16_t*)(P.ws + (f ? WS_W13_2 : WS_W13_1)); d.lddst = DM; d.nrow0 = np; return d; }
    i -= CVT_T_W13;
    if (i < CVT_T_W2) { const int nt = i / 22, kt = i % 22;
        d.src = f ? P.in[I_F2W2] : P.in[I_F1W2]; d.ldsrc = DM; d.col0 = nt * 64; d.k0 = kt * 256; d.gain = nullptr; d.dst = (bf16_t*)(P.ws + (f ? WS_W2_2 : WS_W2_1)); d.lddst = DFF; d.nrow0 = nt * 64; return d; }
    i -= CVT_T_W2;
    if (!f) { const int nt = i >> 3, kt = i & 7, np = nt * 64;
        d.src = P.in[I_WIN]; d.ldsrc = INC; d.col0 = np < 3072 ? np : np + 8; d.k0 = kt * 256; d.gain = P.in[I_MIXN]; d.dst = (bf16_t*)(P.ws + WS_WIN); d.lddst = DM; d.nrow0 = np; return d; }
    if (i < CVT_T_WOUT) { const int nt = i >> 3, kt = i & 7;
        d.src = P.in[I_WOUT]; d.ldsrc = DM; d.col0 = nt * 64; d.k0 = kt * 256; d.gain = nullptr; d.dst = (bf16_t*)(P.ws + WS_WOUT); d.lddst = DM; d.nrow0 = nt * 64; return d; }
    i -= CVT_T_WOUT;
    { const int nt = i >> 2, kt = i & 3;
        d.src = P.in[I_WGLU]; d.ldsrc = 1024; d.col0 = nt * 64; d.k0 = kt * 256; d.gain = nullptr; d.dst = (bf16_t*)(P.ws + WS_WGLU); d.lddst = 1024; d.nrow0 = nt * 64; return d; }
}

struct EpiSwiGLU {
    bf16_t* G; const float* ssq; const float* rw2; const float* rwin; const float* rmixn; unsigned char* rws;
    __device__ __forceinline__ void operator()(AccRef acc, const Unit& u, int wr, int wc, int fr, int fq) const {
        const int row0 = u.pm * 256 + wr * 64 + fr, col0 = u.pn * 128 + wc * 32 + 8 * fq;
        const int slot = u.pn * 64 + u.pm; const bool ride_on = rws != nullptr && slot < 2 * (CVT_T_W2 + CVT_T_WIN);
        CvtDesc cvd; f32x4 cvv[4]; f32x4 cvg;
        if (ride_on) {
            int i = slot >> 1;
            if (i < CVT_T_W2) { const int nt = i / 22, kt = i % 22; cvd.src = rw2; cvd.ldsrc = DM; cvd.col0 = nt * 64; cvd.k0 = kt * 256; cvd.gain = nullptr; cvd.dst = (bf16_t*)(rws + WS_W2_1); cvd.lddst = DFF; cvd.nrow0 = nt * 64; }
            else { i -= CVT_T_W2; const int nt = i >> 3, kt = i & 7, np = nt * 64; cvd.src = rwin; cvd.ldsrc = INC; cvd.col0 = np < 3072 ? np : np + 8; cvd.k0 = kt * 256; cvd.gain = rmixn; cvd.dst = (bf16_t*)(rws + WS_WIN); cvd.lddst = DM; cvd.nrow0 = np; }
            cvd.k0 += (slot & 1) * 128; cvt_load4(cvd, cvv, cvg);
        }
        float rsv[8];
#pragma unroll
        for (int i = 0; i < 8; ++i) rsv[i] = ssq[row0 + (i >> 2) * 128 + (i & 3) * 16];
#pragma unroll
        for (int i = 0; i < 8; ++i) rsv[i] = rs_of(rsv[i], 1.0f / DM);
#pragma unroll
        for (int ai = 0; ai < 2; ++ai)
#pragma unroll
            for (int m = 0; m < 4; ++m) {
                const int r = row0 + ai * 128 + m * 16; const float rs = rsv[ai * 4 + m];
                const float cexp = -1.4426950408889634f * rs, rs2 = rs * rs;
                f32x2 o[4];
#pragma unroll
                for (int n = 0; n < 2; ++n)
#pragma unroll
                    for (int jp = 0; jp < 2; ++jp) {
                        const f32x2 a1 = {acc[ai][0][m][n][2 * jp], acc[ai][0][m][n][2 * jp + 1]}, a3 = {acc[ai][1][m][n][2 * jp], acc[ai][1][m][n][2 * jp + 1]};
                        const f32x2 p = a1 * a3, t = a1 * cexp;
                        f32x2 e; e.x = __builtin_amdgcn_exp2f(t.x); e.y = __builtin_amdgcn_exp2f(t.y);
                        const f32x2 d = e + 1.0f;
                        f32x2 rr; rr.x = __builtin_amdgcn_rcpf(d.x); rr.y = __builtin_amdgcn_rcpf(d.y);
                        o[n * 2 + jp] = (p * rr) * rs2;
                    }
                u32x4 w; w.x = cvt_pk_bf16(o[0].x, o[0].y); w.y = cvt_pk_bf16(o[1].x, o[1].y); w.z = cvt_pk_bf16(o[2].x, o[2].y); w.w = cvt_pk_bf16(o[3].x, o[3].y);
                *(u32x4*)(G + (size_t)r * DFF + col0) = w;
            }
        if (ride_on) cvt_store4(cvd, cvv, cvg);
    }
};
template <bool BASE16> struct EpiResid {
    const float* base32; bf16_t* xb; float* ssq; float scale;
    __device__ __forceinline__ void operator()(AccRef acc, const Unit& u, int wr, int wc, int fr, int fq) const {
        const int row0 = u.pm * 256 + wr * 64 + fr, col0 = u.pn * 256 + wc * 32 + 8 * fq;
        f32x4 nb[4]; u32x4 nh[2]; float sv[8];
        { const size_t off = (size_t)row0 * DM + col0;
          if (BASE16) { nh[0] = *(const u32x4*)(xb + off); nh[1] = *(const u32x4*)(xb + off + 128); }
          else { nb[0] = *(const f32x4*)(base32 + off); nb[1] = *(const f32x4*)(base32 + off + 4); nb[2] = *(const f32x4*)(base32 + off + 128); nb[3] = *(const f32x4*)(base32 + off + 132); } }
#pragma unroll
        for (int i = 0; i < 8; ++i) {
            const int ai = i >> 2, m = i & 3; const int r = row0 + ai * 128 + m * 16;
            f32x4 cb[4];
            if (BASE16) {
#pragma unroll
                for (int q = 0; q < 2; ++q) { cb[q * 2] = (f32x4){bf_lo(nh[q].x), bf_hi(nh[q].x), bf_lo(nh[q].y), bf_hi(nh[q].y)}; cb[q * 2 + 1] = (f32x4){bf_lo(nh[q].z), bf_hi(nh[q].z), bf_lo(nh[q].w), bf_hi(nh[q].w)}; }
            } else {
#pragma unroll
                for (int q = 0; q < 4; ++q) cb[q] = nb[q];
            }
            if (i < 7) { const int r2 = row0 + ((i + 1) >> 2) * 128 + ((i + 1) & 3) * 16; const size_t off = (size_t)r2 * DM + col0;
                if (BASE16) { nh[0] = *(const u32x4*)(xb + off); nh[1] = *(const u32x4*)(xb + off + 128); }
                else { nb[0] = *(const f32x4*)(base32 + off); nb[1] = *(const f32x4*)(base32 + off + 4); nb[2] = *(const f32x4*)(base32 + off + 128); nb[3] = *(const f32x4*)(base32 + off + 132); } }
            float s = 0.f;
#pragma unroll
            for (int bj = 0; bj < 2; ++bj) {
                const size_t off = (size_t)r * DM + col0 + bj * 128;
                const f32x4 v0 = cb[bj * 2] + scale * acc[ai][bj][m][0], v1 = cb[bj * 2 + 1] + scale * acc[ai][bj][m][1];
                s += v0[0] * v0[0] + v0[1] * v0[1] + v0[2] * v0[2] + v0[3] * v0[3] + v1[0] * v1[0] + v1[1] * v1[1] + v1[2] * v1[2] + v1[3] * v1[3];
                u32x4 w; w.x = cvt_pk_bf16(v0[0], v0[1]); w.y = cvt_pk_bf16(v0[2], v0[3]); w.z = cvt_pk_bf16(v1[0], v1[1]); w.w = cvt_pk_bf16(v1[2], v1[3]); *(u32x4*)(xb + off) = w;
            }
            s += __shfl_xor(s, 16); s += __shfl_xor(s, 32);
            sv[i] = s;
        }
        if (fq == 0) {
#pragma unroll
            for (int i = 0; i < 8; ++i) atomicAdd(ssq + row0 + (i >> 2) * 128 + (i & 3) * 16, sv[i]);
        }
    }
};
struct EpiWin {
    bf16_t* QK; bf16_t* V; bf16_t* O; bf16_t* UX; const float* ssq;
    __device__ __forceinline__ void operator()(AccRef acc, const Unit& u, int wr, int wc, int fr, int fq) const {
        const int row0 = u.pm * 256 + wr * 64 + fr, region = u.pn >> 2, colr0 = (u.pn & 3) * 256 + wc * 32 + 8 * fq;
        float rsv[8];
#pragma unroll
        for (int i = 0; i < 8; ++i) rsv[i] = ssq[row0 + (i >> 2) * 128 + (i & 3) * 16];
#pragma unroll
        for (int i = 0; i < 8; ++i) rsv[i] = rs_of(rsv[i], 1.0f / DM);
#pragma unroll
        for (int ai = 0; ai < 2; ++ai)
#pragma unroll
            for (int m = 0; m < 4; ++m) {
                const int r = row0 + ai * 128 + m * 16; const float rs = rsv[ai * 4 + m];
#pragma unroll
                for (int bj = 0; bj < 2; ++bj) {
                    const int colr = colr0 + bj * 128;
                    f32x4 v0 = rs * acc[ai][bj][m][0], v1 = rs * acc[ai][bj][m][1];
                    if (region == 2) {
#pragma unroll
                        for (int j = 0; j < 4; ++j) { v0[j] = sigmoidf_(v0[j]); v1[j] = sigmoidf_(v1[j]); } }
                    u32x4 w; w.x = cvt_pk_bf16(v0[0], v0[1]); w.y = cvt_pk_bf16(v0[2], v0[3]); w.z = cvt_pk_bf16(v1[0], v1[1]); w.w = cvt_pk_bf16(v1[2], v1[3]);
                    bf16_t* dst;
                    if (region == 0) dst = QK + (size_t)r * 1024 + colr;
                    else if (region == 1) dst = V + (size_t)r * 1024 + colr;
                    else if (region == 2) dst = O + (size_t)r * 1024 + colr;
                    else dst = UX + ((size_t)(colr >> 4) * 1024 + (r >> 4)) * 384 + (r & 15) * 16 + (colr & 15);
                    *(u32x4*)dst = w;
                }
            }
    }
};
struct EpiGLU {
    const bf16_t* YS; bf16_t* MIX; const float* bias;
    __device__ __forceinline__ void operator()(AccRef acc, const Unit& u, int wr, int wc, int fr, int fq) const {
        const int row0 = u.pm * 256 + wr * 64 + fr, col0 = u.pn * 256 + wc * 32 + 8 * fq;
        f32x4 bv[4]; u32x4 yv[16];
#pragma unroll
        for (int q = 0; q < 4; ++q) bv[q] = *(const f32x4*)(bias + col0 + (q >> 1) * 128 + (q & 1) * 4);
#pragma unroll
        for (int i = 0; i < 8; ++i)
#pragma unroll
            for (int bj = 0; bj < 2; ++bj) yv[i * 2 + bj] = *(const u32x4*)(YS + (size_t)(row0 + (i >> 2) * 128 + (i & 3) * 16) * 1024 + col0 + bj * 128);
#pragma unroll
        for (int ai = 0; ai < 2; ++ai)
#pragma unroll
            for (int m = 0; m < 4; ++m) {
                const int r = row0 + ai * 128 + m * 16;
#pragma unroll
                for (int bj = 0; bj < 2; ++bj) {
                    const int c = col0 + bj * 128;
                    const u32x4 y = yv[(ai * 4 + m) * 2 + bj];
                    const f32x4 a0 = acc[ai][bj][m][0] + bv[bj * 2], a1 = acc[ai][bj][m][1] + bv[bj * 2 + 1];
                    u32x4 w;
                    w.x = cvt_pk_bf16(bf_lo(y.x) * sigmoidf_(a0[0]), bf_hi(y.x) * sigmoidf_(a0[1]));
                    w.y = cvt_pk_bf16(bf_lo(y.y) * sigmoidf_(a0[2]), bf_hi(y.y) * sigmoidf_(a0[3]));
                    w.z = cvt_pk_bf16(bf_lo(y.z) * sigmoidf_(a1[0]), bf_hi(y.z) * sigmoidf_(a1[1]));
                    w.w = cvt_pk_bf16(bf_lo(y.w) * sigmoidf_(a1[2]), bf_hi(y.w) * sigmoidf_(a1[3]));
                    *(u32x4*)(MIX + (size_t)r * 2048 + 1024 + c) = w;
                }
            }
    }
};

template <class Epi>
__device__ __forceinline__ void sgemm_unit(LAS unsigned char* lds, const bf16_t* A, int lda, const bf16_t* Bt, int ldb, int K, const Epi& E) {
    const int tid = threadIdx.x, w = tid >> 6, lane = tid & 63, fr = lane & 15, fq = lane >> 4, wr = w >> 2, wc = w & 3;
    LAS bf16_t* As = (LAS bf16_t*)lds; LAS bf16_t* Bs = (LAS bf16_t*)(lds + 34816);
    f32x4 acc[4][2];
#pragma unroll
    for (int m = 0; m < 4; ++m)
#pragma unroll
        for (int n = 0; n < 2; ++n) acc[m][n] = (f32x4){0.f, 0.f, 0.f, 0.f};
    u32x4 ra[4], rb[4];
    const int lr0 = tid >> 4, lc = (tid & 15) * 8;
#pragma unroll
    for (int i = 0; i < 4; ++i) { ra[i] = *(const u32x4*)(A + (size_t)(lr0 + 32 * i) * lda + lc); rb[i] = *(const u32x4*)(Bt + (size_t)(lr0 + 32 * i) * ldb + lc); }
    for (int k0 = 0; k0 < K; k0 += 128) {
        LDS_BARRIER();
#pragma unroll
        for (int i = 0; i < 4; ++i) { *(LAS u32x4*)(As + (lr0 + 32 * i) * 136 + lc) = ra[i]; *(LAS u32x4*)(Bs + (lr0 + 32 * i) * 136 + lc) = rb[i]; }
        LDS_BARRIER();
        if (k0 + 128 < K) {
#pragma unroll
            for (int i = 0; i < 4; ++i) { ra[i] = *(const u32x4*)(A + (size_t)(lr0 + 32 * i) * lda + k0 + 128 + lc); rb[i] = *(const u32x4*)(Bt + (size_t)(lr0 + 32 * i) * ldb + k0 + 128 + lc); }
        }
#pragma unroll
        for (int kk = 0; kk < 4; ++kk) {
            bf16x8 af[4], bfv[2];
#pragma unroll
            for (int m = 0; m < 4; ++m) af[m] = *(const LAS bf16x8*)(As + (wr * 64 + m * 16 + fr) * 136 + kk * 32 + fq * 8);
#pragma unroll
            for (int n = 0; n < 2; ++n) bfv[n] = *(const LAS bf16x8*)(Bs + (wc * 32 + n * 16 + fr) * 136 + kk * 32 + fq * 8);
#pragma unroll
            for (int m = 0; m < 4; ++m)
#pragma unroll
                for (int n = 0; n < 2; ++n) acc[m][n] = __builtin_amdgcn_mfma_f32_16x16x32_bf16(bfv[n], af[m], acc[m][n], 0, 0, 0);
        }
    }
#pragma unroll
    for (int m = 0; m < 4; ++m)
#pragma unroll
        for (int n = 0; n < 2; ++n) E(wr * 64 + m * 16 + fr, wc * 32 + n * 16 + 4 * fq, acc[m][n]);
    LDS_BARRIER();
}

__device__ void s5_prep_group(const Params& P, LAS unsigned char* lds, int g) {
    const int tid = threadIdx.x;
    LAS float* Pw = (LAS float*)lds;
    LAS float* Bb = Pw + 17 * 128;
    LAS float* Cc = Bb + 2048;
    LAS float* Kt = Cc + 2048;
    const float dt = __expf(P.in[I_LDT][g]);
    if (tid < 64) {
        const int p = tid; const float lr = P.in[I_LRE][g * 64 + p], li = P.in[I_LIM][g * 64 + p];
        for (int tau = 0; tau <= 16; ++tau) { const float e = __expf(lr * dt * tau); float sn, cs; sincosf(li * dt * tau, &sn, &cs); Pw[(tau * 64 + p) * 2] = e * cs; Pw[(tau * 64 + p) * 2 + 1] = e * sn; }
        float* laml = (float*)(P.ws + WS_SMALL) + SM_LAML;
        laml[(g * 64 + p) * 2] = Pw[(16 * 64 + p) * 2]; laml[(g * 64 + p) * 2 + 1] = Pw[(16 * 64 + p) * 2 + 1];
    }
    for (int i = tid; i < 1024; i += 512) {
        const int p = i >> 4; const float lr = P.in[I_LRE][g * 64 + p], li = P.in[I_LIM][g * 64 + p];
        const float e = __expf(lr * dt); float sn, cs; sincosf(li * dt, &sn, &cs);
        const float nr = e * cs - 1.0f, ni = e * sn, den = 1.0f / (lr * lr + li * li);
        const float fr_ = (nr * lr + ni * li) * den, fi_ = (ni * lr - nr * li) * den;
        const float br = P.in[I_BRE][(size_t)g * 1024 + i], bi = P.in[I_BIM][(size_t)g * 1024 + i];
        Bb[i * 2] = fr_ * br - fi_ * bi; Bb[i * 2 + 1] = fr_ * bi + fi_ * br;
        Cc[i * 2] = P.in[I_CRE][(size_t)g * 1024 + i]; Cc[i * 2 + 1] = P.in[I_CIM][(size_t)g * 1024 + i];
    }
    __syncthreads();
    for (int i = tid; i < 4096; i += 512) {
        const int tau = i >> 8, h = (i >> 4) & 15, hp = i & 15; float s = 0.f;
        for (int p = 0; p < 64; ++p) {
            const float cr = Cc[(h * 64 + p) * 2], ci = Cc[(h * 64 + p) * 2 + 1], pr = Pw[(tau * 64 + p) * 2], pi = Pw[(tau * 64 + p) * 2 + 1];
            const float zr = cr * pr - ci * pi, zi = cr * pi + ci * pr;
            s += zr * Bb[(p * 16 + hp) * 2] - zi * Bb[(p * 16 + hp) * 2 + 1];
        }
        if (tau == 0 && h == hp) s += P.in[I_DSK][g * 16 + h];
        Kt[i] = s;
    }
    __syncthreads();
    bf16_t* btc = (bf16_t*)(P.ws + WS_BTC) + (size_t)g * 256 * 384;
    for (int i = tid; i < 256 * 48; i += 512) {
        const int n = i / 48, k0 = (i % 48) * 8, t = n >> 4, h = n & 15; float o[8];
#pragma unroll
        for (int e = 0; e < 8; ++e) {
            const int k = k0 + e;
            if (k < 256) { const int s = k >> 4, hp = k & 15; o[e] = (t >= s) ? Kt[((t - s) * 16 + h) * 16 + hp] : 0.f; }
            else { const int kk = k - 256, ri = kk >> 6, p = kk & 63; const float cr = Cc[(h * 64 + p) * 2], ci = Cc[(h * 64 + p) * 2 + 1], pr = Pw[((t + 1) * 64 + p) * 2], pi = Pw[((t + 1) * 64 + p) * 2 + 1];
                o[e] = ri == 0 ? (cr * pr - ci * pi) : -(cr * pi + ci * pr); }
        }
        u32x4 w; w.x = cvt_pk_bf16(o[0], o[1]); w.y = cvt_pk_bf16(o[2], o[3]); w.z = cvt_pk_bf16(o[4], o[5]); w.w = cvt_pk_bf16(o[6], o[7]);
        *(u32x4*)(btc + (size_t)n * 384 + k0) = w;
    }
    bf16_t* bte = (bf16_t*)(P.ws + WS_BTE) + (size_t)g * 128 * 256;
    for (int i = tid; i < 128 * 32; i += 512) {
        const int n = i >> 5, k0 = (i & 31) * 8, ri = n >> 6, p = n & 63; float o[8];
#pragma unroll
        for (int e = 0; e < 8; ++e) {
            const int k = k0 + e, s = k >> 4, hp = k & 15;
            const float pr = Pw[((15 - s) * 64 + p) * 2], pi = Pw[((15 - s) * 64 + p) * 2 + 1], br = Bb[(p * 16 + hp) * 2], bi = Bb[(p * 16 + hp) * 2 + 1];
            o[e] = ri == 0 ? (pr * br - pi * bi) : (pr * bi + pi * br);
        }
        u32x4 w; w.x = cvt_pk_bf16(o[0], o[1]); w.y = cvt_pk_bf16(o[2], o[3]); w.z = cvt_pk_bf16(o[4], o[5]); w.w = cvt_pk_bf16(o[6], o[7]);
        *(u32x4*)(bte + (size_t)n * 256 + k0) = w;
    }
    __syncthreads();
}

__device__ void phase_prep(const Params& P, LAS unsigned char* lds) {
    const int tid = threadIdx.x, bid = blockIdx.x, nb = gridDim.x;
    float* sm = (float*)(P.ws + WS_SMALL);
    for (int i = bid * 512 + tid; i < 49152 + 65536; i += nb * 512) sm[SM_SSQ1 + i] = 0.f;
    { bf16_t* wg = (bf16_t*)(P.ws + WS_WG);
      for (int i = bid * 512 + tid; i < 16 * 2048; i += nb * 512) { const int n = i >> 11, k = i & 2047; wg[i] = n < 8 ? f2bf(P.in[I_WIN][(size_t)k * INC + 3072 + n] * P.in[I_MIXN][k]) : (bf16_t)0; } }
    { const int w = tid >> 6, lane = tid & 63; bf16_t* xb = (bf16_t*)(P.ws + WS_XB);
      for (int row = bid * 8 + w; row < T_TOK; row += 2 * nb * 8) {
          const int row2 = row + nb * 8; const bool has2 = row2 < T_TOK;
          const float* xr = P.in[I_X] + (size_t)row * DM; const float* xr2 = P.in[I_X] + (size_t)(has2 ? row2 : row) * DM;
          f32x4 va[8], vb[8];
#pragma unroll
          for (int it = 0; it < 8; ++it) { va[it] = *(const f32x4*)(xr + (it * 64 + lane) * 4); vb[it] = *(const f32x4*)(xr2 + (it * 64 + lane) * 4); }
          float s = 0.f, s2 = 0.f;
#pragma unroll
          for (int it = 0; it < 8; ++it) { const f32x4 v = va[it], u = vb[it];
              s += v[0] * v[0] + v[1] * v[1] + v[2] * v[2] + v[3] * v[3]; s2 += u[0] * u[0] + u[1] * u[1] + u[2] * u[2] + u[3] * u[3];
              u32x2 o; o.x = cvt_pk_bf16(v[0], v[1]); o.y = cvt_pk_bf16(v[2], v[3]); *(u32x2*)(xb + (size_t)row * DM + (it * 64 + lane) * 4) = o;
              if (has2) { u32x2 o2; o2.x = cvt_pk_bf16(u[0], u[1]); o2.y = cvt_pk_bf16(u[2], u[3]); *(u32x2*)(xb + (size_t)row2 * DM + (it * 64 + lane) * 4) = o2; } }
#pragma unroll
          for (int o = 32; o >= 1; o >>= 1) { s += __shfl_xor(s, o); s2 += __shfl_xor(s2, o); }
          if (lane == 0) { sm[SM_SSQ0 + row] = s; if (has2) sm[SM_SSQ0 + row2] = s2; }
      } }
    for (int g = bid; g < 64; g += nb) s5_prep_group(P, lds, g);
    const int nskip = nb > 128 ? 64 : 0, nwk = nb - nskip;
    if (bid >= nskip)
    for (int t = bid - nskip; t < CVT_T_W13; t += 2 * nwk) {
        const CvtDesc d0 = cvt_decode(P, t); f32x4 v0[8]; float g0[8]; cvt_load(d0, v0, g0);
        if (t + nwk < CVT_T_W13) { const CvtDesc d1 = cvt_decode(P, t + nwk); f32x4 v1[8]; float g1[8]; cvt_load(d1, v1, g1); cvt_store(d0, v0, g0); cvt_store(d1, v1, g1); }
        else cvt_store(d0, v0, g0);
    }
}

__device__ void phase_gates(const Params& P, LAS unsigned char* lds) {
    const int tid = threadIdx.x, w = tid >> 6, lane = tid & 63, fr = lane & 15, fq = lane >> 4, half = w & 1;
    const bf16_t* xb = (const bf16_t*)(P.ws + WS_XB); const bf16_t* wg = (const bf16_t*)(P.ws + WS_WG);
    float* sm = (float*)(P.ws + WS_SMALL); LAS f32x4* xch = (LAS f32x4*)lds;
    for (int t0 = blockIdx.x * 4; t0 < T_TOK / 16; t0 += gridDim.x * 4) {
        const int task = t0 + (w >> 1); const bool valid = task < T_TOK / 16;
        const int tok0 = (valid ? task : 0) * 16; f32x4 acc = {0.f, 0.f, 0.f, 0.f};
        const bf16_t* ap = xb + (size_t)(tok0 + fr) * DM + half * 1024 + fq * 8; const bf16_t* bp = wg + (size_t)fr * DM + half * 1024 + fq * 8;
#pragma unroll 16
        for (int kk = 0; kk < 32; ++kk) { const bf16x8 a = *(const bf16x8*)(ap + kk * 32), b = *(const bf16x8*)(bp + kk * 32); acc = __builtin_amdgcn_mfma_f32_16x16x32_bf16(a, b, acc, 0, 0, 0); }
        __syncthreads();
        if (half) xch[(w >> 1) * 64 + lane] = acc;
        __syncthreads();
        if (!half && valid && fr < 8) {
            acc += xch[(w >> 1) * 64 + lane];
            const float bias = fr < 4 ? P.in[I_BI][fr] : P.in[I_BF][fr - 4];
#pragma unroll
            for (int j = 0; j < 4; ++j) { const int tok = tok0 + fq * 4 + j; float v = rs_of(sm[SM_SSQ1 + tok], 1.0f / DM) * acc[j] + bias;
                if (fr >= 4) v = fminf(v, 0.f) - log1pf(__expf(-fabsf(v)));
                sm[SM_GATES + (size_t)tok * 8 + fr] = v; }
        }
    }
}

__device__ void phase_s5_scan(const Params& P) {
    const int tid = threadIdx.x; if (tid >= 128) return;
    const float* __restrict__ E = (const float*)(P.ws + WS_E); bf16_t* __restrict__ UX = (bf16_t*)(P.ws + WS_UX); const float* laml = (const float*)(P.ws + WS_SMALL) + SM_LAML;
    for (int id = blockIdx.x * 128 + tid; id < 8 * 64 * 64; id += gridDim.x * 128) {
        const int p = id & 63, g = (id >> 6) & 63, b = id >> 12;
        const float lr = laml[(g * 64 + p) * 2], li = laml[(g * 64 + p) * 2 + 1]; float xr = 0.f, xi = 0.f;
        const size_t row0 = (size_t)g * 1024 + b * 128;
        for (int c0 = 0; c0 < 128; c0 += 16) {
            float er[16], ei[16];
#pragma unroll
            for (int c = 0; c < 16; ++c) { er[c] = E[(row0 + c0 + c) * 128 + p]; ei[c] = E[(row0 + c0 + c) * 128 + 64 + p]; }
#pragma unroll
            for (int c = 0; c < 16; ++c) {
                UX[(row0 + c0 + c) * 384 + 256 + p] = f2bf(xr); UX[(row0 + c0 + c) * 384 + 320 + p] = f2bf(xi);
                const float nr = lr * xr - li * xi + er[c], ni = lr * xi + li * xr + ei[c]; xr = nr; xi = ni;
            }
        }
    }
}

__device__ void phase_mix_pre(const Params& P, LAS unsigned char* lds) {
    const int tid = threadIdx.x, w = __builtin_amdgcn_readfirstlane(tid >> 6), lane = tid & 63, fr = lane & 15, fq = lane >> 4;
    LAS bf16_t* qs = (LAS bf16_t*)lds; LAS bf16_t* ks = (LAS bf16_t*)(lds + 17408); LAS float* fwp = (LAS float*)(lds + 34816);
    const float* gates = (const float*)(P.ws + WS_SMALL) + SM_GATES; bf16_t* SPg = (bf16_t*)(P.ws + WS_SP);
    const bf16_t* QK = (const bf16_t*)(P.ws + WS_QK); bf16_t* QKC = (bf16_t*)(P.ws + WS_QKC); bf16_t* KT = (bf16_t*)(P.ws + WS_KT);
    const int dg = tid & 31, isK = dg >> 4, d0 = (dg & 15) * 8, tl = tid >> 5;
    const float qscale = isK ? 1.0f : 0.08838834764831845f;
#define MP_LOAD_RAW(dst, tk) do { const int b_ = (tk) >> 7, h_ = ((tk) >> 5) & 3, t0_ = ((tk) & 31) * 64, cc_ = (isK ? 512 : 0) + h_ * 128 + d0; \
        _Pragma("unroll") for (int i_ = 0; i_ < 7; ++i_) { const int pos_ = t0_ + tl * 4 - 3 + i_; dst[i_] = pos_ >= 0 ? *(const u32x4*)(QK + ((size_t)b_ * SEQ + pos_) * 1024 + cc_) : (u32x4){0u, 0u, 0u, 0u}; } } while (0)
    float cw[4][8], cb[8]; int h_prev = -1;
    u32x4 raw[7];
    if ((int)blockIdx.x < 1024) MP_LOAD_RAW(raw, (int)blockIdx.x);
    for (int task = blockIdx.x; task < 1024; task += gridDim.x) {
        const int b = task >> 7, h = (task >> 5) & 3, c = task & 31, t0 = c * 64;
        const int convcol = (isK ? 512 : 0) + h * 128 + d0;
        if (h != h_prev) {
            h_prev = h;
#pragma unroll
            for (int j = 0; j < 4; ++j) { const f32x4 a0 = *(const f32x4*)(P.in[I_CONVW] + j * 1024 + convcol), a1 = *(const f32x4*)(P.in[I_CONVW] + j * 1024 + convcol + 4);
                cw[j][0] = a0[0]; cw[j][1] = a0[1]; cw[j][2] = a0[2]; cw[j][3] = a0[3]; cw[j][4] = a1[0]; cw[j][5] = a1[1]; cw[j][6] = a1[2]; cw[j][7] = a1[3]; }
            { const f32x4 a0 = *(const f32x4*)(P.in[I_CONVB] + convcol), a1 = *(const f32x4*)(P.in[I_CONVB] + convcol + 4);
                cb[0] = a0[0]; cb[1] = a0[1]; cb[2] = a0[2]; cb[3] = a0[3]; cb[4] = a1[0]; cb[5] = a1[1]; cb[6] = a1[2]; cb[7] = a1[3]; }
        }
        u32x4 nraw[7];
#pragma unroll
        for (int i = 0; i < 7; ++i) nraw[i] = (u32x4){0u, 0u, 0u, 0u};
        if (task + (int)gridDim.x < 1024) MP_LOAD_RAW(nraw, task + (int)gridDim.x);
        float o[4][8];
#pragma unroll
        for (int tt = 0; tt < 4; ++tt) {
#pragma unroll
            for (int e = 0; e < 8; ++e) o[tt][e] = cb[e];
#pragma unroll
            for (int j = 0; j < 4; ++j) { const u32x4 x = raw[tt + j];
                o[tt][0] += cw[j][0] * bf_lo(x.x); o[tt][1] += cw[j][1] * bf_hi(x.x); o[tt][2] += cw[j][2] * bf_lo(x.y); o[tt][3] += cw[j][3] * bf_hi(x.y);
                o[tt][4] += cw[j][4] * bf_lo(x.z); o[tt][5] += cw[j][5] * bf_hi(x.z); o[tt][6] += cw[j][6] * bf_lo(x.w); o[tt][7] += cw[j][7] * bf_hi(x.w); }
#pragma unroll
            for (int e = 0; e < 8; ++e) o[tt][e] = siluf_(o[tt][e]) * qscale;
            u32x4 wv; wv.x = cvt_pk_bf16(o[tt][0], o[tt][1]); wv.y = cvt_pk_bf16(o[tt][2], o[tt][3]); wv.z = cvt_pk_bf16(o[tt][4], o[tt][5]); wv.w = cvt_pk_bf16(o[tt][6], o[tt][7]);
            *(u32x4*)(QKC + ((size_t)b * SEQ + t0 + tl * 4 + tt) * 1024 + convcol) = wv;
            *(LAS u32x4*)((isK ? ks : qs) + (tl * 4 + tt) * 136 + d0) = wv;
        }
        if (isK) {
            bf16_t* kt = KT + (size_t)task * 8192 + tl * 4;
#pragma unroll
            for (int e = 0; e < 8; ++e) { u32x2 wv; wv.x = cvt_pk_bf16(o[0][e], o[1][e]); wv.y = cvt_pk_bf16(o[2][e], o[3][e]); *(u32x2*)(kt + (d0 + e) * 64) = wv; }
        }
        if (w == 0) {
            const size_t tok = (size_t)b * SEQ + t0 + lane; const float li = gates[tok * 8 + h]; float x = gates[tok * 8 + 4 + h];
#pragma unroll
            for (int off = 1; off < 64; off <<= 1) { const float t = __shfl_up(x, off); if (lane >= off) x += t; }
            const float wv = li - x; float pm = wv;
#pragma unroll
            for (int off = 1; off < 64; off <<= 1) { const float t = __shfl_up(pm, off); if (lane >= off) pm = fmaxf(pm, t); }
            fwp[lane] = wv; fwp[64 + lane] = pm;
        }
        LDS_BARRIER();
        for (int idx = w; idx < 16; idx += 8) {
            bf16_t* spt = SPg + (size_t)task * 4096;
            if (idx < 10) {
                const int ti = (0xFFA94 >> (2 * idx)) & 3, si = (0xE4910 >> (2 * idx)) & 3;
                f32x4 sT = {0.f, 0.f, 0.f, 0.f};
#pragma unroll
                for (int kk = 0; kk < 4; ++kk) { const bf16x8 a = *(const LAS bf16x8*)(ks + (si * 16 + fr) * 136 + kk * 32 + fq * 8), bb = *(const LAS bf16x8*)(qs + (ti * 16 + fr) * 136 + kk * 32 + fq * 8);
                    sT = __builtin_amdgcn_mfma_f32_16x16x32_bf16(a, bb, sT, 0, 0, 0); }
                const int tr = ti * 16 + fr, sc0 = si * 16 + fq * 4; const float pmt = fwp[64 + tr];
                const f32x4 w4 = *(const LAS f32x4*)(fwp + sc0);
                float vv[4];
#pragma unroll
                for (int j = 0; j < 4; ++j) vv[j] = (sc0 + j <= tr) ? sT[j] * fexp(w4[j] - pmt) : 0.f;
                u32x2 pk; pk.x = cvt_pk_bf16(vv[0], vv[1]); pk.y = cvt_pk_bf16(vv[2], vv[3]);
                *(u32x2*)(spt + tr * 64 + sc0) = pk;
            } else {
                const int k = idx - 10, ti = (k >= 3) + (k >= 5), si = k < 3 ? k + 1 : (k < 5 ? k - 1 : 3);
                *(u32x2*)(spt + (ti * 16 + fr) * 64 + si * 16 + fq * 4) = (u32x2){0u, 0u};
            }
        }
        LDS_BARRIER();
#pragma unroll
        for (int i = 0; i < 7; ++i) raw[i] = nraw[i];
    }
#undef MP_LOAD_RAW
}

__device__ void mlstm_item(const Params& P, LAS unsigned char* lds, int item, float* ssqh) {
    const int tid = threadIdx.x, w = __builtin_amdgcn_readfirstlane(tid >> 6), lane = tid & 63, fr = lane & 15, fq = lane >> 4;
    const int pair = (item & 7) * 4 + (item >> 6), js = (item >> 3) & 7, b = pair >> 2, h = pair & 3;
    LAS bf16_t* qs = (LAS bf16_t*)(lds);
    LAS bf16_t* ks = (LAS bf16_t*)(lds + 17408);
    LAS bf16_t* kT = (LAS bf16_t*)(lds + 34816);
    LAS bf16_t* vT = (LAS bf16_t*)(lds + 53248);
    LAS bf16_t* vTd = (LAS bf16_t*)(lds + 60160);
    LAS bf16_t* Sp = (LAS bf16_t*)(lds + 67072);
    LAS bf16_t* Cb = (LAS bf16_t*)(lds + 76288);
    LAS float* fw = (LAS float*)(lds + 89344);
    LAS float* fM = fw + 64; LAS float* fa = fw + 128; LAS float* fen = fw + 192; LAS float* fd63 = fw + 256;
    const bf16_t* QKC = (const bf16_t*)(P.ws + WS_QKC); const bf16_t* KT = (const bf16_t*)(P.ws + WS_KT); const bf16_t* SPt = (const bf16_t*)(P.ws + WS_SP); const bf16_t* V = (const bf16_t*)(P.ws + WS_V); bf16_t* MIX = (bf16_t*)(P.ws + WS_MIX);
    const float* gates = (const float*)(P.ws + WS_SMALL) + SM_GATES;
    __syncthreads();
    for (int i = tid; i < 64 * 72; i += 512) Sp[i] = 0;
    for (int i = tid; i < 16 * 72; i += 512) { const bf16_t v = (i < 72) ? (bf16_t)0x3F80 : (bf16_t)0; vT[32 * 72 + i] = v; vTd[32 * 72 + i] = 0; }
    const int qrow = tid >> 4, qch = (tid & 15) * 8, ktrow = tid >> 3, ktch = (tid & 7) * 8, task0 = (b * 4 + h) * 32;
    f32x4 Cacc[3][2];
#pragma unroll
    for (int a = 0; a < 3; ++a)
#pragma unroll
        for (int c2 = 0; c2 < 2; ++c2) Cacc[a][c2] = (f32x4){0.f, 0.f, 0.f, 0.f};
    float m_prev = 0.f;
    LAS float* gsl = (LAS float*)(lds + 90624);
    for (int cc = w; cc < 32; cc += 8) {
        const size_t tok = (size_t)b * SEQ + cc * 64 + lane;
        const float li = gates[tok * 8 + h]; float x = gates[tok * 8 + 4 + h];
#pragma unroll
        for (int off = 1; off < 64; off <<= 1) { const float t = __shfl_up(x, off); if (lane >= off) x += t; }
        const float wv = li - x; float pm = wv;
#pragma unroll
        for (int off = 1; off < 64; off <<= 1) { const float t = __shfl_up(pm, off); if (lane >= off) pm = fmaxf(pm, t); }
        gsl[cc * 192 + lane] = wv; gsl[cc * 192 + 64 + lane] = pm; gsl[cc * 192 + 128 + lane] = x;
    }
    __syncthreads();
    u32x4 rq[2], rkt[2], rsp; u32x4 vraw = {0u, 0u, 0u, 0u};
    const int vs = (tid >> 2) & 63, vcg = tid & 3;
#define ML_PREFETCH(cc) do { const size_t tbn_ = (size_t)b * SEQ + (cc) * 64; const int task_ = task0 + (cc); \
        _Pragma("unroll") for (int i_ = 0; i_ < 2; ++i_) { rq[i_] = *(const u32x4*)(QKC + (tbn_ + qrow + 32 * i_) * 1024 + h * 128 + qch); \
            rkt[i_] = *(const u32x4*)(KT + (size_t)task_ * 8192 + (ktrow + 64 * i_) * 64 + ktch); } \
        rsp = *(const u32x4*)(SPt + (size_t)task_ * 4096 + tid * 8); \
        if (w >= 4) vraw = *(const u32x4*)(V + (tbn_ + vs) * 1024 + h * 256 + js * 32 + vcg * 8); \
        } while (0)
    ML_PREFETCH(0);
    const CvtDesc cvdflt = cvt_decode(P, CVT_EARLY);
    CvtDesc cvdA = cvdflt, cvdB = cvdflt; f32x4 cvvA[4], cvvB[4]; f32x4 cvgA, cvgB; bool pendA = false, pendB = false;
    u32x2 hold0 = {0u, 0u}, hold1 = {0u, 0u}; bf16_t* hold_dst = MIX;
    auto chunk_body = [&](const int c, CvtDesc& cvd, f32x4 (&cvv)[4], f32x4& cvg, bool& cv_pend) __attribute__((always_inline)) {
        const int t0 = c * 64; const size_t tokbase = (size_t)b * SEQ + t0;
#pragma unroll
        for (int i = 0; i < 2; ++i) { *(LAS u32x4*)(qs + (qrow + 32 * i) * 136 + qch) = rq[i]; *(LAS u32x4*)(kT + (ktrow + 64 * i) * 72 + ktch) = rkt[i]; }
        *(LAS u32x4*)(Sp + (tid >> 3) * 72 + (tid & 7) * 8) = rsp;
        const LAS float* gc = gsl + c * 192;
        const float M63 = fmaxf(m_prev, gc[127]), a63 = fexp(m_prev - M63), m_next = gc[191] + M63;
        if (w >= 4) {
            LAS bf16_t* d = vT + (vcg * 8) * 72 + vs;
            d[0] = (bf16_t)(vraw.x & 0xffff); d[72] = (bf16_t)(vraw.x >> 16); d[144] = (bf16_t)(vraw.y & 0xffff); d[216] = (bf16_t)(vraw.y >> 16);
            d[288] = (bf16_t)(vraw.z & 0xffff); d[360] = (bf16_t)(vraw.z >> 16); d[432] = (bf16_t)(vraw.w & 0xffff); d[504] = (bf16_t)(vraw.w >> 16);
            { const float d = fexp(gc[vs] - M63); LAS bf16_t* dd = vTd + (vcg * 8) * 72 + vs;
              dd[0] = f2bf(bf_lo(vraw.x) * d); dd[72] = f2bf(bf_hi(vraw.x) * d); dd[144] = f2bf(bf_lo(vraw.y) * d); dd[216] = f2bf(bf_hi(vraw.y) * d);
              dd[288] = f2bf(bf_lo(vraw.z) * d); dd[360] = f2bf(bf_hi(vraw.z) * d); dd[432] = f2bf(bf_lo(vraw.w) * d); dd[504] = f2bf(bf_hi(vraw.w) * d);
              if (vcg == 0) vTd[32 * 72 + vs] = f2bf(d); }
#pragma unroll
            for (int vt = 0; vt < 3; ++vt)
#pragma unroll
                for (int k2 = 0; k2 < 2; ++k2) { u32x2 pk; pk.x = cvt_pk_bf16(Cacc[vt][k2][0], Cacc[vt][k2][1]); pk.y = cvt_pk_bf16(Cacc[vt][k2][2], Cacc[vt][k2][3]);
                    *(LAS u32x2*)(Cb + (vt * 16 + fr) * 136 + ((w - 4) * 2 + k2) * 16 + fq * 4) = pk; }
        }
        if (cv_pend) cvt_store4(cvd, cvv, cvg);
        if (w < 4 && c > 0) { *(u32x2*)hold_dst = hold0; *(u32x2*)(hold_dst + 16) = hold1; }
        if (c + 1 < 32) ML_PREFETCH(c + 1);
        {
          const int cvt_h = c * (int)gridDim.x + (int)blockIdx.x; cv_pend = cvt_h < 2 * (CVT_TOT - CVT_EARLY);
          if (cv_pend) { cvd = cvt_decode(P, CVT_EARLY + (cvt_h >> 1)); cvd.k0 += (cvt_h & 1) * 128; } else cvd = cvdflt;
          cvt_load4(cvd, cvv, cvg); }
        LDS_BARRIER();
        f32x4 o2[3];
        if (w < 4) {
#pragma unroll
            for (int vt = 0; vt < 3; ++vt) o2[vt] = (f32x4){0.f, 0.f, 0.f, 0.f};
#pragma unroll
            for (int kk = 0; kk < 4; ++kk) { const bf16x8 bb = *(const LAS bf16x8*)(qs + (w * 16 + fr) * 136 + kk * 32 + fq * 8);
#pragma unroll
                for (int vt = 0; vt < 3; ++vt) { const bf16x8 a = *(const LAS bf16x8*)(Cb + (vt * 16 + fr) * 136 + kk * 32 + fq * 8); o2[vt] = __builtin_amdgcn_mfma_f32_16x16x32_bf16(a, bb, o2[vt], 0, 0, 0); } }
        }
        if (w < 4) {
            const int ti = w; f32x4 o1[3];
#pragma unroll
            for (int vt = 0; vt < 3; ++vt) o1[vt] = (f32x4){0.f, 0.f, 0.f, 0.f};
#pragma unroll
            for (int kk = 0; kk < 2; ++kk) { const bf16x8 bb = *(const LAS bf16x8*)(Sp + (ti * 16 + fr) * 72 + kk * 32 + fq * 8);
#pragma unroll
                for (int vt = 0; vt < 3; ++vt) { const bf16x8 a = *(const LAS bf16x8*)(vT + (vt * 16 + fr) * 72 + kk * 32 + fq * 8); o1[vt] = __builtin_amdgcn_mfma_f32_16x16x32_bf16(a, bb, o1[vt], 0, 0, 0); } }
            {
                const int tr = ti * 16 + fr; const float Mt = fmaxf(m_prev, gc[64 + tr]); const float at = fexp(m_prev - Mt), en = fexp(-(gc[128 + tr] + Mt)), ft = fexp(gc[64 + tr] - Mt);
#pragma unroll
                for (int vt = 0; vt < 3; ++vt) o1[vt] = o1[vt] * ft;
                const float dn = o1[2][0] + at * o2[2][0]; const float den = __shfl(dn, fr);
                const float inv = frcp(fmaxf(fabsf(den), en));
                hold_dst = MIX + (tokbase + tr) * 2048 + h * 256 + js * 32 + fq * 4;
                hold0.x = cvt_pk_bf16((o1[0][0] + at * o2[0][0]) * inv, (o1[0][1] + at * o2[0][1]) * inv); hold0.y = cvt_pk_bf16((o1[0][2] + at * o2[0][2]) * inv, (o1[0][3] + at * o2[0][3]) * inv);
                hold1.x = cvt_pk_bf16((o1[1][0] + at * o2[1][0]) * inv, (o1[1][1] + at * o2[1][1]) * inv); hold1.y = cvt_pk_bf16((o1[1][2] + at * o2[1][2]) * inv, (o1[1][3] + at * o2[1][3]) * inv);
            }
        } else {
#pragma unroll
            for (int vt = 0; vt < 3; ++vt)
#pragma unroll
                for (int k2 = 0; k2 < 2; ++k2) Cacc[vt][k2] = Cacc[vt][k2] * a63;
#pragma unroll
            for (int kk = 0; kk < 2; ++kk) {
                bf16x8 a[3], bb[2];
#pragma unroll
                for (int vt = 0; vt < 3; ++vt) a[vt] = *(const LAS bf16x8*)(vTd + (vt * 16 + fr) * 72 + kk * 32 + fq * 8);
#pragma unroll
                for (int k2 = 0; k2 < 2; ++k2) bb[k2] = *(const LAS bf16x8*)(kT + (((w - 4) * 2 + k2) * 16 + fr) * 72 + kk * 32 + fq * 8);
#pragma unroll
                for (int vt = 0; vt < 3; ++vt)
#pragma unroll
                    for (int k2 = 0; k2 < 2; ++k2) Cacc[vt][k2] = __builtin_amdgcn_mfma_f32_16x16x32_bf16(bb[k2], a[vt], Cacc[vt][k2], 0, 0, 0);
            }
        }
        m_prev = m_next;
        LDS_BARRIER();
        };
    for (int c2 = 0; c2 < 16; ++c2) { chunk_body(2 * c2, cvdA, cvvA, cvgA, pendA); chunk_body(2 * c2 + 1, cvdB, cvvB, cvgB, pendB); }
    if (pendA) cvt_store4(cvdA, cvvA, cvgA);
    if (pendB) cvt_store4(cvdB, cvvB, cvgB);
    if (w < 4) { *(u32x2*)hold_dst = hold0; *(u32x2*)(hold_dst + 16) = hold1; }
#undef ML_PREFETCH
}

__device__ void phase_hm_finalize(const Params& P) {
    bf16_t* MIX = (bf16_t*)(P.ws + WS_MIX); const bf16_t* O = (const bf16_t*)(P.ws + WS_O);
    const float* gn = P.in[I_MLN];
    for (size_t i = (size_t)blockIdx.x * 512 + threadIdx.x; i < (size_t)T_TOK * 128; i += (size_t)gridDim.x * 512) {
        const size_t t = i >> 7; const int c = (int)(i & 127) * 8;
        const u32x4 hv = *(const u32x4*)(MIX + t * 2048 + c), ov = *(const u32x4*)(O + t * 1024 + c);
        const f32x4 g0 = *(const f32x4*)(gn + c), g1 = *(const f32x4*)(gn + c + 4);
        const float h0 = bf_lo(hv.x), h1 = bf_hi(hv.x), h2 = bf_lo(hv.y), h3 = bf_hi(hv.y), h4 = bf_lo(hv.z), h5 = bf_hi(hv.z), h6 = bf_lo(hv.w), h7 = bf_hi(hv.w);
        float ss = h0 * h0 + h1 * h1 + h2 * h2 + h3 * h3 + h4 * h4 + h5 * h5 + h6 * h6 + h7 * h7;
        ss += __shfl_xor(ss, 1); ss += __shfl_xor(ss, 2); ss += __shfl_xor(ss, 4); ss += __shfl_xor(ss, 8); ss += __shfl_xor(ss, 16);
        const float rs = rs_of(ss, 1.0f / 256.0f);
        u32x4 w;
        w.x = cvt_pk_bf16(h0 * rs * g0[0] * bf_lo(ov.x), h1 * rs * g0[1] * bf_hi(ov.x));
        w.y = cvt_pk_bf16(h2 * rs * g0[2] * bf_lo(ov.y), h3 * rs * g0[3] * bf_hi(ov.y));
        w.z = cvt_pk_bf16(h4 * rs * g1[0] * bf_lo(ov.z), h5 * rs * g1[1] * bf_hi(ov.z));
        w.w = cvt_pk_bf16(h6 * rs * g1[2] * bf_lo(ov.w), h7 * rs * g1[3] * bf_hi(ov.w));
        *(u32x4*)(MIX + t * 2048 + c) = w;
    }
}
__device__ void phase_final_norm(const Params& P) {
    const float* ssq = (const float*)(P.ws + WS_SMALL) + SM_SSQ3; const float* gn = P.in[I_FINN]; const bf16_t* XBp = (const bf16_t*)(P.ws + WS_XB);
#pragma unroll 2
    for (size_t i = (size_t)blockIdx.x * 512 + threadIdx.x; i < (size_t)T_TOK * 256; i += (size_t)gridDim.x * 512) {
        const size_t t = i >> 8; const int c = (int)(i & 255) * 8;
        const float rs = rs_of(ssq[t], 1.0f / DM);
        const u32x4 xv = *(const u32x4*)(XBp + t * DM + c); const f32x4 g0 = *(const f32x4*)(gn + c), g1 = *(const f32x4*)(gn + c + 4);
        const f32x4 o0 = {bf_lo(xv.x) * rs * g0[0], bf_hi(xv.x) * rs * g0[1], bf_lo(xv.y) * rs * g0[2], bf_hi(xv.y) * rs * g0[3]};
        const f32x4 o1 = {bf_lo(xv.z) * rs * g1[0], bf_hi(xv.z) * rs * g1[1], bf_lo(xv.w) * rs * g1[2], bf_hi(xv.w) * rs * g1[3]};
        *(f32x4*)(P.out + t * DM + c) = o0; *(f32x4*)(P.out + t * DM + c + 4) = o1;
    }
}

struct EpiE { float* E; __device__ __forceinline__ void operator()(int r, int c, const f32x4& v) const { *(f32x4*)(E + (size_t)r * 128 + c) = v; } };
struct EpiY { bf16_t* YS; int g, nt; __device__ __forceinline__ void operator()(int r, int c, const f32x4& v) const {
    const int n = nt * 128 + c, t = n >> 4, h = n & 15; u32x2 w; w.x = cvt_pk_bf16(gelu_tanh(v[0]), gelu_tanh(v[1])); w.y = cvt_pk_bf16(gelu_tanh(v[2]), gelu_tanh(v[3]));
    *(u32x2*)(YS + ((size_t)r * 16 + t) * 1024 + g * 16 + h) = w; } };

#define PROBE 0
#define DUP_P1 0
#define DUP_MLSTM 0
#define PROBE_AMASK 0xFFF
#define PROBE_BMASK 0x001
#if PROBE
#define TS(i) do { if (blockIdx.x == 0 && threadIdx.x == 0) ((unsigned long long*)(P.ws + WS_SMALL) + SM_ENDF)[i] = __builtin_amdgcn_s_memrealtime(); } while (0)
#else
#define TS(i) do { } while (0)
#endif
#define XB_TMO      128
#define XB_XCNT(j)  (256  + 64 * (j))
#define XB_XSUB(j)  (1280 + 64 * (j))
#define XB_XGEN(j)  (2304 + 64 * (j))
#define XB_TOP      3328
#define XB_TOPGEN   3392
#define XCD_BAR_WORDS 3456
#define XB_SPIN_CAP (1u << 18)

__device__ __forceinline__ unsigned xb_ld(unsigned* p)              { return __hip_atomic_load(p, __ATOMIC_RELAXED, __HIP_MEMORY_SCOPE_AGENT); }
__device__ __forceinline__ unsigned xb_add(unsigned* p, unsigned v) { return __hip_atomic_fetch_add(p, v, __ATOMIC_RELAXED, __HIP_MEMORY_SCOPE_AGENT); }
__device__ __forceinline__ unsigned xb_xcc_id() { return (unsigned)__builtin_amdgcn_s_getreg((3 << 11) | 20) & 0xFu; }
#define XB_SPIN(cond, bar) do { unsigned _sp = 0; while (cond) { __builtin_amdgcn_s_sleep(1); \
    if ((++_sp & 255u) == 0u) { if (xb_ld(&(bar)[XB_TMO])) break; if (_sp > XB_SPIN_CAP) { atomicAdd(&(bar)[XB_TMO], 1u); break; } } } } while (0)

struct XcdBarrier {
    unsigned* bar; unsigned x;
    volatile LAS unsigned* st;
};

__device__ __forceinline__ XcdBarrier xcd_barrier_post(unsigned* bar, volatile LAS unsigned* st) {
    XcdBarrier b; b.bar = bar; b.x = xb_xcc_id(); b.st = st;
    if (threadIdx.x == 0) (void)xb_add(&bar[XB_XCNT(b.x)], 1u);
    return b;
}
__device__ __forceinline__ void xcd_barrier_complete(unsigned* bar, unsigned x, unsigned& nloc, unsigned& nx) {
    const unsigned G = gridDim.x * gridDim.y * gridDim.z;
    unsigned sum, cnt, mine, sp = 0u;
    for (;;) {
        sum = 0u; cnt = 0u; mine = 0u;
#pragma unroll
        for (unsigned j = 0; j < 16; ++j) { const unsigned c = xb_ld(&bar[XB_XCNT(j)]); sum += c; cnt += (c > 0u) ? 1u : 0u; mine = (j == x) ? c : mine; }
        if (sum == G) break;
        __builtin_amdgcn_s_sleep(1);
        if ((++sp & 255u) == 0u) { if (xb_ld(&bar[XB_TMO])) break; if (sp > XB_SPIN_CAP) { atomicAdd(&bar[XB_TMO], 1u); break; } }
    }
    nloc = mine > 0u ? mine : 1u; nx = cnt > 0u ? cnt : 1u;
}

__device__ __forceinline__ void xcd_barrier(const XcdBarrier& b) {
    asm volatile("s_waitcnt vmcnt(0)" ::: "memory");
    __syncthreads();
    if (threadIdx.x == 0) {
        unsigned* bar = b.bar;
        __builtin_amdgcn_s_waitcnt(0);
        unsigned nloc = b.st[0], nx = b.st[1];
        if (nloc == 0u) { xcd_barrier_complete(bar, b.x, nloc, nx); b.st[0] = nloc; b.st[1] = nx; }
        const unsigned old = xb_add(&bar[XB_XSUB(b.x)], 1u);
        const unsigned gen = old / nloc;
        if (old + 1u == (gen + 1u) * nloc) {
            __builtin_amdgcn_fence(__ATOMIC_RELEASE, "agent");
            asm volatile("s_waitcnt vmcnt(0)" ::: "memory");
            const unsigned og = xb_add(&bar[XB_TOP], 1u);
            const unsigned tg = og / nx;
            if (og + 1u == (tg + 1u) * nx) xb_add(&bar[XB_TOPGEN], 1u);
            else XB_SPIN(xb_ld(&bar[XB_TOPGEN]) == tg, bar);
            __builtin_amdgcn_fence(__ATOMIC_ACQUIRE, "agent");
            xb_add(&bar[XB_XGEN(b.x)], 1u);
            asm volatile("s_waitcnt vmcnt(0)" ::: "memory");
        } else {
            XB_SPIN(xb_ld(&bar[XB_XGEN(b.x)]) == gen, bar);
            __builtin_amdgcn_fence(__ATOMIC_ACQUIRE, "agent");
            asm volatile("s_waitcnt vmcnt(0)" ::: "memory");
        }
    }
    __syncthreads();
}


#define GRID_SYNC_CG() do { asm volatile("s_waitcnt vmcnt(0) lgkmcnt(0)" ::: "memory"); grid.sync(); } while (0)
#define GRID_SYNC() xcd_barrier(xb)
__global__ void __launch_bounds__(512, 2) fwd_megakernel(Params P) {
    extern __shared__ __attribute__((aligned(16))) unsigned char shm_raw[];
    LAS unsigned char* lds = (LAS unsigned char*)shm_raw;
    cg::grid_group grid = cg::this_grid();
    float* sm = (float*)(P.ws + WS_SMALL);
    bf16_t* XB = (bf16_t*)(P.ws + WS_XB); bf16_t* G = (bf16_t*)(P.ws + WS_G); bf16_t* MIX = (bf16_t*)(P.ws + WS_MIX);
    pg8::StaticOrder S;
    volatile LAS unsigned* xst = (volatile LAS unsigned*)(lds + 131072);
    if (threadIdx.x < 2) xst[threadIdx.x] = 0u;
    __syncthreads();
    const XcdBarrier xb = xcd_barrier_post((unsigned*)(P.ws + WS_BAR), xst);
    TS(0);
    phase_prep(P, lds);
    if (P.out == nullptr) GRID_SYNC_CG();
    GRID_SYNC(); TS(1);
    { pg8::Gemm g{XB, (const bf16_t*)(P.ws + WS_W13_1), T_TOK, 2 * DFF, DM, DM, DM}; S.init(g.M, g.N, gridDim.x, blockIdx.x);
      EpiSwiGLU e{G, sm + SM_SSQ0, P.in[I_F1W2], P.in[I_WIN], P.in[I_MIXN], P.ws}; pg8::gemm_phase(lds, g, S, e);
#if DUP_P1
      __syncthreads(); pg8::gemm_phase(lds, g, S, e);
#endif
    }
    GRID_SYNC(); TS(2);
    { pg8::Gemm g{G, (const bf16_t*)(P.ws + WS_W2_1), T_TOK, DM, DFF, DFF, DFF}; S.init(g.M, g.N, gridDim.x, blockIdx.x);
      EpiResid<true> e{nullptr, XB, sm + SM_SSQ1, 0.5f}; pg8::gemm_phase(lds, g, S, e); }
    GRID_SYNC(); TS(3);
    { pg8::Gemm g{XB, (const bf16_t*)(P.ws + WS_WIN), T_TOK, 4096, DM, DM, DM}; S.init(g.M, g.N, gridDim.x, blockIdx.x);
      EpiWin e{(bf16_t*)(P.ws + WS_QK), (bf16_t*)(P.ws + WS_V), (bf16_t*)(P.ws + WS_O), (bf16_t*)(P.ws + WS_UX), sm + SM_SSQ1}; pg8::gemm_phase(lds, g, S, e); }
    phase_gates(P, lds);
    GRID_SYNC(); TS(4);
    phase_mix_pre(P, lds);
    __syncthreads();
    for (int id = blockIdx.x; id < 512; id += gridDim.x) { const int g = id >> 3, mt = id & 7;
        EpiE e{(float*)(P.ws + WS_E) + ((size_t)g * 1024 + mt * 128) * 128};
        sgemm_unit(lds, (const bf16_t*)(P.ws + WS_UX) + ((size_t)g * 1024 + mt * 128) * 384, 384, (const bf16_t*)(P.ws + WS_BTE) + (size_t)g * 128 * 256, 256, 256, e); }
    GRID_SYNC(); TS(5);
    phase_s5_scan(P);
    for (int it = blockIdx.x; it < 256; it += gridDim.x) mlstm_item(P, lds, it, sm + SM_SSQH);
#if DUP_MLSTM
    phase_s5_scan(P);
    for (int it = blockIdx.x; it < 256; it += gridDim.x) mlstm_item(P, lds, it, sm + SM_ENDF + 1024);
#endif
    GRID_SYNC(); TS(6);
    for (int id = blockIdx.x; id < 1024; id += gridDim.x) { const int g = id >> 4, mt = (id >> 1) & 7, nt = id & 1;
        EpiY e{(bf16_t*)(P.ws + WS_YS) + (size_t)(mt * 128) * 16 * 1024, g, nt};
        sgemm_unit(lds, (const bf16_t*)(P.ws + WS_UX) + ((size_t)g * 1024 + mt * 128) * 384, 384, (const bf16_t*)(P.ws + WS_BTC) + ((size_t)g * 256 + nt * 128) * 384, 384, 384, e); }
    phase_hm_finalize(P);
    GRID_SYNC(); TS(7);
    { pg8::Gemm g{(const bf16_t*)(P.ws + WS_YS), (const bf16_t*)(P.ws + WS_WGLU), T_TOK, 1024, 1024, 1024, 1024}; S.init(g.M, g.N, gridDim.x, blockIdx.x);
      EpiGLU e{(const bf16_t*)(P.ws + WS_YS), MIX, P.in[I_BGLU]}; pg8::gemm_phase(lds, g, S, e); }
    GRID_SYNC(); TS(8);
    { pg8::Gemm g{MIX, (const bf16_t*)(P.ws + WS_WOUT), T_TOK, DM, DM, DM, DM}; S.init(g.M, g.N, gridDim.x, blockIdx.x);
      EpiResid<true> e{nullptr, XB, sm + SM_SSQ2, 1.0f}; pg8::gemm_phase(lds, g, S, e); }
    GRID_SYNC(); TS(9);
    { pg8::Gemm g{XB, (const bf16_t*)(P.ws + WS_W13_2), T_TOK, 2 * DFF, DM, DM, DM}; S.init(g.M, g.N, gridDim.x, blockIdx.x);
      EpiSwiGLU e{G, sm + SM_SSQ2, nullptr, nullptr, nullptr, nullptr}; pg8::gemm_phase(lds, g, S, e); }
    GRID_SYNC(); TS(10);
    { pg8::Gemm g{G, (const bf16_t*)(P.ws + WS_W2_2), T_TOK, DM, DFF, DFF, DFF}; S.init(g.M, g.N, gridDim.x, blockIdx.x);
      EpiResid<true> e{nullptr, XB, sm + SM_SSQ3, 0.5f}; pg8::gemm_phase(lds, g, S, e); }
    GRID_SYNC(); TS(11);
    phase_final_norm(P);
#if PROBE
    GRID_SYNC(); TS(12);
    if (blockIdx.x == 0 && threadIdx.x == 0) {
        float sa = 0.f, sb = 0.f; const unsigned long long* tsv = (const unsigned long long*)(P.ws + WS_SMALL) + SM_ENDF;
        const int amask = PROBE_AMASK, bmask = PROBE_BMASK;
#pragma unroll
        for (int i = 0; i < 12; ++i) { const float d = (float)(tsv[i + 1] - tsv[i]) * 0.01f; if ((amask >> i) & 1) sa += d; if ((bmask >> i) & 1) sb += d; }
        P.out[0] += sa; for (int i = 1; i <= 100; ++i) P.out[i] += sb;
    }
#endif
}

extern "C" void kernel_launch(void* const* d_in, const int* in_sizes, int n_in, void* d_out, int out_size, void* d_ws, size_t ws_size, hipStream_t stream) {
    static int grid = 0;
    if (grid == 0) {
        if (n_in != 28 || ws_size < WS_END) { fprintf(stderr, "kernel_launch: unexpected n_in %d / ws_size %zu (need %zu)\n", n_in, ws_size, (size_t)WS_END); grid = -1; return; }
        int dev = 0, cus = 0, per_cu = 0;
        hipGetDevice(&dev); hipDeviceGetAttribute(&cus, hipDeviceAttributeMultiprocessorCount, dev);
        if (hipFuncSetAttribute((const void*)fwd_megakernel, hipFuncAttributeMaxDynamicSharedMemorySize, LDS_BYTES) != hipSuccess) { fprintf(stderr, "kernel_launch: hipFuncSetAttribute failed\n"); grid = -1; return; }
        if (hipOccupancyMaxActiveBlocksPerMultiprocessor(&per_cu, (const void*)fwd_megakernel, 512, LDS_BYTES) != hipSuccess || per_cu < 1) { fprintf(stderr, "kernel_launch: occupancy query gave %d\n", per_cu); per_cu = 1; }
        (void)hipGetLastError();
        grid = cus;
        if (grid > 256) grid = 256;
    }
    if (grid < 0) return;
    Params p{};
    for (int i = 0; i < 28; ++i) p.in[i] = (const float*)d_in[i];
    p.out = (float*)d_out; p.ws = (unsigned char*)d_ws;
    if (hipMemsetAsync((char*)d_ws + WS_BAR, 0, XCD_BAR_WORDS * sizeof(unsigned), stream) != hipSuccess) { fprintf(stderr, "kernel_launch: memset of barrier words failed\n"); return; }
    void* args[] = {&p};
    hipError_t e = hipLaunchCooperativeKernel((const void*)fwd_megakernel, dim3(grid), dim3(512), args, LDS_BYTES, stream);
    if (e != hipSuccess) fprintf(stderr, "cooperative launch failed: %s (grid %d)\n", hipGetErrorString(e), grid);
}
```

```cpp
#include <hip/hip_runtime.h>
#include <hip/hip_cooperative_groups.h>
#include <cstdio>
namespace cg = cooperative_groups;

#define LAS __attribute__((address_space(3)))
typedef unsigned short bf16_t;
typedef short bf16x8 __attribute__((ext_vector_type(8)));
typedef float f32x4 __attribute__((ext_vector_type(4)));
typedef float f32x2 __attribute__((ext_vector_type(2)));
typedef unsigned u32x4 __attribute__((ext_vector_type(4)));
typedef unsigned u32x2 __attribute__((ext_vector_type(2)));

constexpr int T_TOK = 16384, DM = 2048, DFF = 5632, SEQ = 2048;
constexpr int INC = 4104;
constexpr float EPS = 1e-6f;
constexpr int LDS_BYTES = 131072 + 64;
constexpr size_t MiB = 1024 * 1024;
constexpr size_t WS_W13_1 = 0, WS_W2_1 = 44 * MiB, WS_W13_2 = 66 * MiB, WS_W2_2 = 110 * MiB, WS_WIN = 132 * MiB, WS_WOUT = 148 * MiB,
                 WS_WGLU = 156 * MiB, WS_BTC = 158 * MiB, WS_BTE = 170 * MiB, WS_WG = 174 * MiB, WS_SMALL = 175 * MiB, WS_BAR = 177 * MiB,
                 WS_XB = 178 * MiB, WS_G = 242 * MiB, WS_MIX = 418 * MiB, WS_QKC = WS_W13_1  , WS_KT = 32 * MiB, WS_SP = 48 * MiB, WS_END = 482 * MiB;
constexpr size_t WS_QK = WS_G, WS_V = WS_G + 32 * MiB, WS_O = WS_G + 64 * MiB, WS_UX = WS_G + 96 * MiB, WS_E = WS_G + 144 * MiB, WS_YS = WS_QK;
constexpr size_t SM_SSQ0 = 0, SM_SSQ1 = 16384, SM_SSQ2 = 32768, SM_SSQ3 = 49152, SM_SSQH = 65536, SM_GATES = 131072, SM_LAML = 262144, SM_GS = 262144 + 8192, SM_ENDF = 262144 + 8192 + 196608;

struct Params { const float* in[28]; float* out; unsigned char* ws; };
enum { I_X = 0, I_F1N, I_F1W1, I_F1W3, I_F1W2, I_MIXN, I_WIN, I_CONVW, I_CONVB, I_BI, I_BF, I_MLN, I_LRE, I_LIM, I_LDT, I_BRE, I_BIM, I_CRE, I_CIM, I_DSK,
       I_WGLU, I_BGLU, I_WOUT, I_F2N, I_F2W1, I_F2W3, I_F2W2, I_FINN };

__device__ __forceinline__ unsigned cvt_pk_bf16(float lo, float hi) { unsigned r; asm volatile("v_cvt_pk_bf16_f32 %0, %1, %2" : "=v"(r) : "v"(lo), "v"(hi)); return r; }
__device__ __forceinline__ float bf_lo(unsigned u) { return __uint_as_float(u << 16); }
__device__ __forceinline__ float bf_hi(unsigned u) { return __uint_as_float(u & 0xffff0000u); }
__device__ __forceinline__ float bf2f(bf16_t b) { return __uint_as_float(((unsigned)b) << 16); }
__device__ __forceinline__ bf16_t f2bf(float f) { return (bf16_t)(cvt_pk_bf16(f, 0.f) & 0xffffu); }
__device__ __forceinline__ float frcp(float x) { return __builtin_amdgcn_rcpf(x); }
__device__ __forceinline__ float fexp(float x) { return __builtin_amdgcn_exp2f(x * 1.4426950408889634f); }
__device__ __forceinline__ float sigmoidf_(float x) { return frcp(1.0f + fexp(-x)); }
__device__ __forceinline__ float siluf_(float x) { return x * frcp(1.0f + fexp(-x)); }
__device__ __forceinline__ float gelu_tanh(float x) { const float u = 0.7978845608f * (x + 0.044715f * x * x * x); return x * frcp(1.0f + fexp(-2.0f * u)); }
__device__ __forceinline__ float rs_of(float ssq, float inv_n) { return rsqrtf(ssq * inv_n + EPS); }

namespace pg8 {
constexpr int BM = 256, BK = 64, HALF = 128, HTB = HALF * BK * 2, NXCD = 8, WGM = 8;
__host__ __device__ __forceinline__ int lds_byte(int r, int c) { const int st = (r >> 4) * 2 + (c >> 5), rr = r & 15, cc = c & 31, ob = rr * 64 + cc * 2; return st * 1024 + (ob ^ (((ob >> 9) & 1) << 5)); }
__host__ __device__ __forceinline__ void stage_rc(int b, int& R, int& C) { const int st = b / 1024, sb = b % 1024, swz = sb ^ (((sb >> 9) & 1) << 5); R = (st >> 1) * 16 + swz / 64; C = (st & 1) * 32 + (swz % 64) / 2; }
__host__ __device__ __forceinline__ int perm32(int rho) { const int n = rho >> 4, i = rho & 15; return 8 * (i >> 2) + 4 * n + (i & 3); }
struct Unit { int pm, pn; };
struct Gemm { const bf16_t* A; const bf16_t* Bt; int M, N, K, lda, ldb; };
struct StaticOrder {
    int nM, nN, nwg, G, c;
    __device__ void init(int M, int N, int G_, int c_) { nM = M / BM; nN = N / BM; nwg = nM * nN; G = G_; c = c_; }
    __device__ bool next(int i, Unit& u) const {
        const long L = (long)i * G + c; if (L >= nwg) return false;
        int wgid = (int)L; { const int q = nwg / NXCD, r = nwg % NXCD, xcd = wgid % NXCD, off = wgid / NXCD; wgid = (xcd < r ? xcd * (q + 1) : r * (q + 1) + (xcd - r) * q) + off; }
        const int nig = WGM * nN, gid = wgid / nig, fm = gid * WGM, gsz = (nM - fm) < WGM ? (nM - fm) : WGM;
        u.pm = fm + ((wgid % nig) % gsz); u.pn = (wgid % nig) / gsz; return true;
    }
};
template <class Epi>
__device__ __forceinline__ void gemm_phase(LAS unsigned char* lds, const Gemm g, const StaticOrder& S, const Epi& E) {
    int tid = threadIdx.x; asm volatile("" : "+v"(tid));
    const int wid = __builtin_amdgcn_readfirstlane(tid >> 6), lane = tid & 63, wr = wid >> 2, wc = wid & 3, fr = lane & 15, fq = lane >> 4;
    const int K = g.K, nt = K / BK;
    unsigned voffA[2], voffB[2];
#pragma unroll
    for (int i = 0; i < 2; ++i) { int R, C; stage_rc(tid * 16 + i * 8192, R, C); const int Rb = (R & ~31) + perm32(R & 31);
        voffA[i] = (unsigned)(R * g.lda + C) * 2u; voffB[i] = (unsigned)(Rb * g.ldb + C) * 2u; }
    const size_t kstep = (size_t)(BK * 2);
    const size_t hstepA = (size_t)HALF * g.lda * 2, hstepB = (size_t)HALF * g.ldb * 2;
    const size_t tstepA = 2 * hstepA, tstepB = 2 * hstepB;
    const unsigned ldsw = (unsigned)wid * 1024u;
    const int aoff = lds_byte(wr * 64 + fr, fq * 8), boff = lds_byte(wc * 32 + fr, fq * 8);
#define PG8_SA(b, h) (((b) * 2 + (h)) * HTB)
#define PG8_SB(b, h) ((4 + (b) * 2 + (h)) * HTB)
#define PG8_STAGE(bufoff, gbase, voff) do { _Pragma("unroll") for (int _i = 0; _i < 2; ++_i) \
        __builtin_amdgcn_global_load_lds((const unsigned*)((const char*)(gbase) + (voff)[_i]), (LAS unsigned*)(lds + (bufoff) + ldsw + _i * 8192), 16, 0, 0); } while (0)
#define PG8_LDA(dst, b, h) do { _Pragma("unroll") for (int m = 0; m < 4; ++m) _Pragma("unroll") for (int k = 0; k < 2; ++k) dst[m][k] = *(const LAS bf16x8*)(lds + PG8_SA(b, h) + aoff + m * 2048 + k * 1024); } while (0)
#define PG8_LDB(dst, b, h) do { _Pragma("unroll") for (int n = 0; n < 2; ++n) _Pragma("unroll") for (int k = 0; k < 2; ++k) dst[n][k] = *(const LAS bf16x8*)(lds + PG8_SB(b, h) + boff + n * 2048 + k * 1024); } while (0)
#define PG8_MMA(ai, bj, At, Bt) do { __builtin_amdgcn_s_setprio(1); _Pragma("unroll") for (int m = 0; m < 4; ++m) _Pragma("unroll") for (int n = 0; n < 2; ++n) _Pragma("unroll") for (int k = 0; k < 2; ++k) \
        acc[ai][bj][m][n] = __builtin_amdgcn_mfma_f32_16x16x32_bf16(Bt[n][k], At[m][k], acc[ai][bj][m][n], 0, 0, 0); __builtin_amdgcn_s_setprio(0); } while (0)
#define PG8_WAIT_V(n) asm volatile("s_waitcnt vmcnt(" #n ")" ::: "memory")
#define PG8_WAIT_L(n) asm volatile("s_waitcnt lgkmcnt(" #n ")" ::: "memory")
#define PG8_BAR __builtin_amdgcn_s_barrier()
#define PG8_SCHED __builtin_amdgcn_sched_barrier(0)
    Unit cur, nxt; int ui = 0;
    if (!S.next(0, cur)) return;
    f32x4 acc[2][2][4][2];
#pragma unroll
    for (int a = 0; a < 2; ++a)
#pragma unroll
        for (int b = 0; b < 2; ++b)
#pragma unroll
            for (int m = 0; m < 4; ++m)
#pragma unroll
                for (int n = 0; n < 2; ++n) acc[a][b][m][n] = (f32x4){0.f, 0.f, 0.f, 0.f};
    bf16x8 At[4][2], B0[2][2], B1[2][2];
    const char* cA = (const char*)g.A + (size_t)cur.pm * tstepA; const char* cB = (const char*)g.Bt + (size_t)cur.pn * tstepB;
    PG8_STAGE(PG8_SB(0, 0), cB, voffB); PG8_STAGE(PG8_SA(0, 0), cA, voffA); PG8_STAGE(PG8_SB(0, 1), cB + hstepB, voffB); PG8_STAGE(PG8_SA(0, 1), cA + hstepA, voffA);
    if (wr == 1) PG8_BAR;
    PG8_WAIT_V(4); PG8_BAR;
    PG8_STAGE(PG8_SB(1, 0), cB + kstep, voffB); PG8_STAGE(PG8_SA(1, 0), cA + kstep, voffA); PG8_STAGE(PG8_SB(1, 1), cB + hstepB + kstep, voffB);
    PG8_WAIT_V(6); PG8_BAR;
    for (;;) {
        const bool has_next = S.next(ui + 1, nxt);
        const char* nA = has_next ? (const char*)g.A + (size_t)nxt.pm * tstepA : cA; const char* nB = has_next ? (const char*)g.Bt + (size_t)nxt.pn * tstepB : cB;
        for (int t = 0; t < nt; t += 2) {
            const bool last = (t == nt - 2);
            const char* a1 = cA + (size_t)(t + 1) * kstep;
            const char* a2 = last ? nA : cA + (size_t)(t + 2) * kstep; const char* b2 = last ? nB : cB + (size_t)(t + 2) * kstep;
            const char* a3 = a2 + kstep; const char* b3 = b2 + kstep;
            PG8_LDB(B0, 0, 0); PG8_SCHED; PG8_LDA(At, 0, 0); PG8_STAGE(PG8_SA(1, 1), a1 + hstepA, voffA);
            PG8_WAIT_L(8); PG8_BAR; PG8_WAIT_L(0); PG8_MMA(0, 0, At, B0); PG8_BAR; PG8_SCHED;
            PG8_LDB(B1, 0, 1); PG8_STAGE(PG8_SB(0, 0), b2, voffB);
            PG8_BAR; PG8_WAIT_L(0); PG8_MMA(0, 1, At, B1); PG8_BAR;
            PG8_LDA(At, 0, 1); PG8_STAGE(PG8_SA(0, 0), a2, voffA);
            PG8_BAR; PG8_WAIT_L(0); PG8_MMA(1, 0, At, B0); PG8_BAR; PG8_SCHED;
            PG8_STAGE(PG8_SB(0, 1), b2 + hstepB, voffB);
            PG8_WAIT_V(6); PG8_BAR; PG8_MMA(1, 1, At, B1); PG8_BAR;
            PG8_LDB(B0, 1, 0); PG8_SCHED; PG8_LDA(At, 1, 0); PG8_STAGE(PG8_SA(0, 1), a2 + hstepA, voffA);
            PG8_WAIT_L(8); PG8_BAR; PG8_WAIT_L(0); PG8_MMA(0, 0, At, B0); PG8_BAR; PG8_SCHED;
            PG8_LDB(B1, 1, 1); PG8_STAGE(PG8_SB(1, 0), b3, voffB);
            PG8_BAR; PG8_WAIT_L(0); PG8_MMA(0, 1, At, B1); PG8_BAR;
            PG8_LDA(At, 1, 1); PG8_STAGE(PG8_SA(1, 0), a3, voffA);
            PG8_BAR; PG8_WAIT_L(0); PG8_MMA(1, 0, At, B0); PG8_BAR; PG8_SCHED;
            PG8_STAGE(PG8_SB(1, 1), b3 + hstepB, voffB);
            PG8_WAIT_V(6); PG8_BAR; PG8_MMA(1, 1, At, B1); PG8_BAR;
        }
        { int t2 = threadIdx.x; asm volatile("" : "+v"(t2)); const int w2 = __builtin_amdgcn_readfirstlane(t2 >> 6), l2 = t2 & 63; E(acc, cur, w2 >> 2, w2 & 3, l2 & 15, l2 >> 4); }
        if (!has_next) break;
#pragma unroll
        for (int a = 0; a < 2; ++a)
#pragma unroll
            for (int b = 0; b < 2; ++b)
#pragma unroll
                for (int m = 0; m < 4; ++m)
#pragma unroll
                    for (int n = 0; n < 2; ++n) acc[a][b][m][n] = (f32x4){0.f, 0.f, 0.f, 0.f};
        cur = nxt; cA = nA; cB = nB; ++ui;
    }
    PG8_WAIT_V(0);
    if (wr == 0) PG8_BAR;
    PG8_BAR;
#undef PG8_SA
#undef PG8_SB
#undef PG8_STAGE
#undef PG8_LDA
#undef PG8_LDB
#undef PG8_MMA
#undef PG8_WAIT_V
#undef PG8_WAIT_L
#undef PG8_BAR
#undef PG8_SCHED
}
}
using pg8::Unit;
typedef const f32x4 (&AccRef)[2][2][4][2];

struct CvtDesc { const float* src; const float* gain; bf16_t* dst; int ldsrc, col0, k0, lddst, nrow0; };
__device__ __forceinline__ void cvt_load(const CvtDesc& d, f32x4 (&v)[8], float (&g)[8]) {
    const int tid = threadIdx.x, r8 = tid >> 4, c4 = (tid & 15) * 4;
#pragma unroll
    for (int i = 0; i < 8; ++i) v[i] = __builtin_nontemporal_load((const f32x4*)(d.src + (size_t)(d.k0 + r8 * 8 + i) * d.ldsrc + d.col0 + c4));
    if (d.gain) { const f32x4 g0 = *(const f32x4*)(d.gain + d.k0 + r8 * 8), g1 = *(const f32x4*)(d.gain + d.k0 + r8 * 8 + 4);
        g[0] = g0[0]; g[1] = g0[1]; g[2] = g0[2]; g[3] = g0[3]; g[4] = g1[0]; g[5] = g1[1]; g[6] = g1[2]; g[7] = g1[3]; }
    else {
#pragma unroll
        for (int i = 0; i < 8; ++i) g[i] = 1.0f; }
}
__device__ __forceinline__ void cvt_load4(const CvtDesc& d, f32x4 (&v)[4], f32x4& g) {
    const int tid = threadIdx.x, r4 = tid >> 4, c4 = (tid & 15) * 4;
#pragma unroll
    for (int i = 0; i < 4; ++i) v[i] = __builtin_nontemporal_load((const f32x4*)(d.src + (size_t)(d.k0 + r4 * 4 + i) * d.ldsrc + d.col0 + c4));
    g = d.gain ? *(const f32x4*)(d.gain + d.k0 + r4 * 4) : (f32x4){1.f, 1.f, 1.f, 1.f};
}
__device__ __forceinline__ void cvt_store4(const CvtDesc& d, const f32x4 (&v)[4], const f32x4& g) {
    const int tid = threadIdx.x, r4 = tid >> 4, c4 = (tid & 15) * 4;
#pragma unroll
    for (int j = 0; j < 4; ++j) {
        u32x2 w; w.x = cvt_pk_bf16(v[0][j] * g[0], v[1][j] * g[1]); w.y = cvt_pk_bf16(v[2][j] * g[2], v[3][j] * g[3]);
        *(u32x2*)(d.dst + (size_t)(d.nrow0 + c4 + j) * d.lddst + d.k0 + r4 * 4) = w;
    }
}
__device__ __forceinline__ void cvt_store(const CvtDesc& d, const f32x4 (&v)[8], const float (&g)[8]) {
    const int tid = threadIdx.x, r8 = tid >> 4, c4 = (tid & 15) * 4;
#pragma unroll
    for (int j = 0; j < 4; ++j) {
        u32x4 w; w.x = cvt_pk_bf16(v[0][j] * g[0], v[1][j] * g[1]); w.y = cvt_pk_bf16(v[2][j] * g[2], v[3][j] * g[3]); w.z = cvt_pk_bf16(v[4][j] * g[4], v[5][j] * g[5]); w.w = cvt_pk_bf16(v[6][j] * g[6], v[7][j] * g[7]);
        *(u32x4*)(d.dst + (size_t)(d.nrow0 + c4 + j) * d.lddst + d.k0 + r8 * 8) = w;
    }
}
constexpr int CVT_T_W13 = 176 * 8, CVT_T_W2 = 32 * 22, CVT_T_WIN = 64 * 8, CVT_T_WOUT = 32 * 8, CVT_T_WGLU = 16 * 4;
constexpr int CVT_EARLY = CVT_T_W13 + CVT_T_W2 + CVT_T_WIN, CVT_TOT = CVT_EARLY + CVT_T_W13 + CVT_T_W2 + CVT_T_WOUT + CVT_T_WGLU;
__device__ __forceinline__ CvtDesc cvt_decode(const Params& P, int t) {
    CvtDesc d; int i = t; int f = 0;
    if (i >= CVT_EARLY) { i -= CVT_EARLY; f = 1; }
    if (i < CVT_T_W13) { const int nt = i >> 3, kt = i & 7; const int np = nt * 64, pn = np >> 8, bj = (np >> 7) & 1, ii = np & 127;
        { const float* a1 = f ? P.in[I_F2W1] : P.in[I_F1W1]; const float* a3 = f ? P.in[I_F2W3] : P.in[I_F1W3]; d.src = bj ? a3 : a1; } d.ldsrc = DFF; d.col0 = pn * 128 + ii; d.k0 = kt * 256; d.gain = f ? P.in[I_F2N] : P.in[I_F1N];
        d.dst = (bf16_t*)(P.ws + (f ? WS_W13_2 : WS_W13_1)); d.lddst = DM; d.nrow0 = np; return d; }
    i -= CVT_T_W13;
    if (i < CVT_T_W2) { const int nt = i / 22, kt = i % 22;
        d.src = f ? P.in[I_F2W2] : P.in[I_F1W2]; d.ldsrc = DM; d.col0 = nt * 64; d.k0 = kt * 256; d.gain = nullptr; d.dst = (bf16_t*)(P.ws + (f ? WS_W2_2 : WS_W2_1)); d.lddst = DFF; d.nrow0 = nt * 64; return d; }
    i -= CVT_T_W2;
    if (!f) { const int nt = i >> 3, kt = i & 7, np = nt * 64;
        d.src = P.in[I_WIN]; d.ldsrc = INC; d.col0 = np < 3072 ? np : np + 8; d.k0 = kt * 256; d.gain = P.in[I_MIXN]; d.dst = (bf16_t*)(P.ws + WS_WIN); d.lddst = DM; d.nrow0 = np; return d; }
    if (i < CVT_T_WOUT) { const int nt = i >> 3, kt = i & 7;
        d.src = P.in[I_WOUT]; d.ldsrc = DM; d.col0 = nt * 64; d.k0 = kt * 256; d.gain = nullptr; d.dst = (bf16_t*)(P.ws + WS_WOUT); d.lddst = DM; d.nrow0 = nt * 64; return d; }
    i -= CVT_T_WOUT;
    { const int nt = i >> 2, kt = i & 3;
        d.src = P.in[I_WGLU]; d.ldsrc = 1024; d.col0 = nt * 64; d.k0 = kt * 256; d.gain = nullptr; d.dst = (bf16_t*)(P.ws + WS_WGLU); d.lddst = 1024; d.nrow0 = nt * 64; return d; }
}

struct EpiSwiGLU {
    bf16_t* G; const float* ssq; const float* rw2; const float* rwin; const float* rmixn; unsigned char* rws;
    __device__ __forceinline__ void operator()(AccRef acc, const Unit& u, int wr, int wc, int fr, int fq) const {
        const int row0 = u.pm * 256 + wr * 64 + fr, col0 = u.pn * 128 + wc * 32 + 8 * fq;
        const int slot = u.pn * 64 + u.pm; const bool ride_on = rws != nullptr && slot < 2 * (CVT_T_W2 + CVT_T_WIN);
        CvtDesc cvd; f32x4 cvv[4]; f32x4 cvg;
        if (ride_on) {
            int i = slot >> 1;
            if (i < CVT_T_W2) { const int nt = i / 22, kt = i % 22; cvd.src = rw2; cvd.ldsrc = DM; cvd.col0 = nt * 64; cvd.k0 = kt * 256; cvd.gain = nullptr; cvd.dst = (bf16_t*)(rws + WS_W2_1); cvd.lddst = DFF; cvd.nrow0 = nt * 64; }
            else { i -= CVT_T_W2; const int nt = i >> 3, kt = i & 7, np = nt * 64; cvd.src = rwin; cvd.ldsrc = INC; cvd.col0 = np < 3072 ? np : np + 8; cvd.k0 = kt * 256; cvd.gain = rmixn; cvd.dst = (bf16_t*)(rws + WS_WIN); cvd.lddst = DM; cvd.nrow0 = np; }
            cvd.k0 += (slot & 1) * 128; cvt_load4(cvd, cvv, cvg);
        }
        float rsv[8];
#pragma unroll
        for (int i = 0; i < 8; ++i) rsv[i] = ssq[row0 + (i >> 2) * 128 + (i & 3) * 16];
#pragma unroll
        for (int i = 0; i < 8; ++i) rsv[i] = rs_of(rsv[i], 1.0f / DM);
#pragma unroll
        for (int ai = 0; ai < 2; ++ai)
#pragma unroll
            for (int m = 0; m < 4; ++m) {
                const int r = row0 + ai * 128 + m * 16; const float rs = rsv[ai * 4 + m];
                const float cexp = -1.4426950408889634f * rs, rs2 = rs * rs;
                f32x2 o[4];
#pragma unroll
                for (int n = 0; n < 2; ++n)
#pragma unroll
                    for (int jp = 0; jp < 2; ++jp) {
                        const f32x2 a1 = {acc[ai][0][m][n][2 * jp], acc[ai][0][m][n][2 * jp + 1]}, a3 = {acc[ai][1][m][n][2 * jp], acc[ai][1][m][n][2 * jp + 1]};
                        const f32x2 p = a1 * a3, t = a1 * cexp;
                        f32x2 e; e.x = __builtin_amdgcn_exp2f(t.x); e.y = __builtin_amdgcn_exp2f(t.y);
                        const f32x2 d = e + 1.0f;
                        f32x2 rr; rr.x = __builtin_amdgcn_rcpf(d.x); rr.y = __builtin_amdgcn_rcpf(d.y);
                        o[n * 2 + jp] = (p * rr) * rs2;
                    }
                u32x4 w; w.x = cvt_pk_bf16(o[0].x, o[0].y); w.y = cvt_pk_bf16(o[1].x, o[1].y); w.z = cvt_pk_bf16(o[2].x, o[2].y); w.w = cvt_pk_bf16(o[3].x, o[3].y);
                *(u32x4*)(G + (size_t)r * DFF + col0) = w;
            }
        if (ride_on) cvt_store4(cvd, cvv, cvg);
    }
};
template <bool BASE16> struct EpiResid {
    const float* base32; bf16_t* xb; float* ssq; float scale;
    __device__ __forceinline__ void operator()(AccRef acc, const Unit& u, int wr, int wc, int fr, int fq) const {
        const int row0 = u.pm * 256 + wr * 64 + fr, col0 = u.pn * 256 + wc * 32 + 8 * fq;
        f32x4 nb[4]; u32x4 nh[2]; float sv[8];
        { const size_t off = (size_t)row0 * DM + col0;
          if (BASE16) { nh[0] = *(const u32x4*)(xb + off); nh[1] = *(const u32x4*)(xb + off + 128); }
          else { nb[0] = *(const f32x4*)(base32 + off); nb[1] = *(const f32x4*)(base32 + off + 4); nb[2] = *(const f32x4*)(base32 + off + 128); nb[3] = *(const f32x4*)(base32 + off + 132); } }
#pragma unroll
        for (int i = 0; i < 8; ++i) {
            const int ai = i >> 2, m = i & 3; const int r = row0 + ai * 128 + m * 16;
            f32x4 cb[4];
            if (BASE16) {
#pragma unroll
                for (int q = 0; q < 2; ++q) { cb[q * 2] = (f32x4){bf_lo(nh[q].x), bf_hi(nh[q].x), bf_lo(nh[q].y), bf_hi(nh[q].y)}; cb[q * 2 + 1] = (f32x4){bf_lo(nh[q].z), bf_hi(nh[q].z), bf_lo(nh[q].w), bf_hi(nh[q].w)}; }
            } else {
#pragma unroll
                for (int q = 0; q < 4; ++q) cb[q] = nb[q];
            }
            if (i < 7) { const int r2 = row0 + ((i + 1) >> 2) * 128 + ((i + 1) & 3) * 16; const size_t off = (size_t)r2 * DM + col0;
                if (BASE16) { nh[0] = *(const u32x4*)(xb + off); nh[1] = *(const u32x4*)(xb + off + 128); }
                else { nb[0] = *(const f32x4*)(base32 + off); nb[1] = *(const f32x4*)(base32 + off + 4); nb[2] = *(const f32x4*)(base32 + off + 128); nb[3] = *(const f32x4*)(base32 + off + 132); } }
            float s = 0.f;
#pragma unroll
            for (int bj = 0; bj < 2; ++bj) {
                const size_t off = (size_t)r * DM + col0 + bj * 128;
                const f32x4 v0 = cb[bj * 2] + scale * acc[ai][bj][m][0], v1 = cb[bj * 2 + 1] + scale * acc[ai][bj][m][1];
                s += v0[0] * v0[0] + v0[1] * v0[1] + v0[2] * v0[2] + v0[3] * v0[3] + v1[0] * v1[0] + v1[1] * v1[1] + v1[2] * v1[2] + v1[3] * v1[3];
                u32x4 w; w.x = cvt_pk_bf16(v0[0], v0[1]); w.y = cvt_pk_bf16(v0[2], v0[3]); w.z = cvt_pk_bf16(v1[0], v1[1]); w.w = cvt_pk_bf16(v1[2], v1[3]); *(u32x4*)(xb + off) = w;
            }
            s += __shfl_xor(s, 16); s += __shfl_xor(s, 32);
            sv[i] = s;
        }
        if (fq == 0) {
#pragma unroll
            for (int i = 0; i < 8; ++i) atomicAdd(ssq + row0 + (i >> 2) * 128 + (i & 3) * 16, sv[i]);
        }
    }
};
struct EpiWin {
    bf16_t* QK; bf16_t* V; bf16_t* O; bf16_t* UX; const float* ssq;
    __device__ __forceinline__ void operator()(AccRef acc, const Unit& u, int wr, int wc, int fr, int fq) const {
        const int row0 = u.pm * 256 + wr * 64 + fr, region = u.pn >> 2, colr0 = (u.pn & 3) * 256 + wc * 32 + 8 * fq;
        float rsv[8];
#pragma unroll
        for (int i = 0; i < 8; ++i) rsv[i] = ssq[row0 + (i >> 2) * 128 + (i & 3) * 16];
#pragma unroll
        for (int i = 0; i < 8; ++i) rsv[i] = rs_of(rsv[i], 1.0f / DM);
#pragma unroll
        for (int ai = 0; ai < 2; ++ai)
#pragma unroll
            for (int m = 0; m < 4; ++m) {
                const int r = row0 + ai * 128 + m * 16; const float rs = rsv[ai * 4 + m];
#pragma unroll
                for (int bj = 0; bj < 2; ++bj) {
                    const int colr = colr0 + bj * 128;
                    f32x4 v0 = rs * acc[ai][bj][m][0], v1 = rs * acc[ai][bj][m][1];
                    if (region == 2) {
#pragma unroll
                        for (int j = 0; j < 4; ++j) { v0[j] = sigmoidf_(v0[j]); v1[j] = sigmoidf_(v1[j]); } }
                    u32x4 w; w.x = cvt_pk_bf16(v0[0], v0[1]); w.y = cvt_pk_bf16(v0[2], v0[3]); w.z = cvt_pk_bf16(v1[0], v1[1]); w.w = cvt_pk_bf16(v1[2], v1[3]);
                    bf16_t* dst;
                    if (region == 0) dst = QK + (size_t)r * 1024 + colr;
                    else if (region == 1) dst = V + (size_t)r * 1024 + colr;
                    else if (region == 2) dst = O + (size_t)r * 1024 + colr;
                    else dst = UX + ((size_t)(colr >> 4) * 1024 + (r >> 4)) * 384 + (r & 15) * 16 + (colr & 15);
                    *(u32x4*)dst = w;
                }
            }
    }
};
struct EpiGLU {
    const bf16_t* YS; bf16_t* MIX; const float* bias;
    __device__ __forceinline__ void operator()(AccRef acc, const Unit& u, int wr, int wc, int fr, int fq) const {
        const int row0 = u.pm * 256 + wr * 64 + fr, col0 = u.pn * 256 + wc * 32 + 8 * fq;
        f32x4 bv[4]; u32x4 yv[16];
#pragma unroll
        for (int q = 0; q < 4; ++q) bv[q] = *(const f32x4*)(bias + col0 + (q >> 1) * 128 + (q & 1) * 4);
#pragma unroll
        for (int i = 0; i < 8; ++i)
#pragma unroll
            for (int bj = 0; bj < 2; ++bj) yv[i * 2 + bj] = *(const u32x4*)(YS + (size_t)(row0 + (i >> 2) * 128 + (i & 3) * 16) * 1024 + col0 + bj * 128);
#pragma unroll
        for (int ai = 0; ai < 2; ++ai)
#pragma unroll
            for (int m = 0; m < 4; ++m) {
                const int r = row0 + ai * 128 + m * 16;
#pragma unroll
                for (int bj = 0; bj < 2; ++bj) {
                    const int c = col0 + bj * 128;
                    const u32x4 y = yv[(ai * 4 + m) * 2 + bj];
                    const f32x4 a0 = acc[ai][bj][m][0] + bv[bj * 2], a1 = acc[ai][bj][m][1] + bv[bj * 2 + 1];
                    u32x4 w;
                    w.x = cvt_pk_bf16(bf_lo(y.x) * sigmoidf_(a0[0]), bf_hi(y.x) * sigmoidf_(a0[1]));
                    w.y = cvt_pk_bf16(bf_lo(y.y) * sigmoidf_(a0[2]), bf_hi(y.y) * sigmoidf_(a0[3]));
                    w.z = cvt_pk_bf16(bf_lo(y.z) * sigmoidf_(a1[0]), bf_hi(y.z) * sigmoidf_(a1[1]));
                    w.w = cvt_pk_bf16(bf_lo(y.w) * sigmoidf_(a1[2]), bf_hi(y.w) * sigmoidf_(a1[3]));
                    *(u32x4*)(MIX + (size_t)r * 2048 + 1024 + c) = w;
                }
            }
    }
};

template <class Epi>
__device__ __forceinline__ void sgemm_unit(LAS unsigned char* lds, const bf16_t* A, int lda, const bf16_t* Bt, int ldb, int K, const Epi& E) {
    const int tid = threadIdx.x, w = tid >> 6, lane = tid & 63, fr = lane & 15, fq = lane >> 4, wr = w >> 2, wc = w & 3;
    LAS bf16_t* As = (LAS bf16_t*)lds; LAS bf16_t* Bs = (LAS bf16_t*)(lds + 34816);
    f32x4 acc[4][2];
#pragma unroll
    for (int m = 0; m < 4; ++m)
#pragma unroll
        for (int n = 0; n < 2; ++n) acc[m][n] = (f32x4){0.f, 0.f, 0.f, 0.f};
    u32x4 ra[4], rb[4];
    const int lr0 = tid >> 4, lc = (tid & 15) * 8;
#pragma unroll
    for (int i = 0; i < 4; ++i) { ra[i] = *(const u32x4*)(A + (size_t)(lr0 + 32 * i) * lda + lc); rb[i] = *(const u32x4*)(Bt + (size_t)(lr0 + 32 * i) * ldb + lc); }
    for (int k0 = 0; k0 < K; k0 += 128) {
        __syncthreads();
#pragma unroll
        for (int i = 0; i < 4; ++i) { *(LAS u32x4*)(As + (lr0 + 32 * i) * 136 + lc) = ra[i]; *(LAS u32x4*)(Bs + (lr0 + 32 * i) * 136 + lc) = rb[i]; }
        __syncthreads();
        if (k0 + 128 < K) {
#pragma unroll
            for (int i = 0; i < 4; ++i) { ra[i] = *(const u32x4*)(A + (size_t)(lr0 + 32 * i) * lda + k0 + 128 + lc); rb[i] = *(const u32x4*)(Bt + (size_t)(lr0 + 32 * i) * ldb + k0 + 128 + lc); }
        }
#pragma unroll
        for (int kk = 0; kk < 4; ++kk) {
            bf16x8 af[4], bfv[2];
#pragma unroll
            for (int m = 0; m < 4; ++m) af[m] = *(const LAS bf16x8*)(As + (wr * 64 + m * 16 + fr) * 136 + kk * 32 + fq * 8);
#pragma unroll
            for (int n = 0; n < 2; ++n) bfv[n] = *(const LAS bf16x8*)(Bs + (wc * 32 + n * 16 + fr) * 136 + kk * 32 + fq * 8);
#pragma unroll
            for (int m = 0; m < 4; ++m)
#pragma unroll
                for (int n = 0; n < 2; ++n) acc[m][n] = __builtin_amdgcn_mfma_f32_16x16x32_bf16(bfv[n], af[m], acc[m][n], 0, 0, 0);
        }
    }
#pragma unroll
    for (int m = 0; m < 4; ++m)
#pragma unroll
        for (int n = 0; n < 2; ++n) E(wr * 64 + m * 16 + fr, wc * 32 + n * 16 + 4 * fq, acc[m][n]);
    __syncthreads();
}

__device__ void s5_prep_group(const Params& P, LAS unsigned char* lds, int g) {
    const int tid = threadIdx.x;
    LAS float* Pw = (LAS float*)lds;
    LAS float* Bb = Pw + 17 * 128;
    LAS float* Cc = Bb + 2048;
    LAS float* Kt = Cc + 2048;
    const float dt = __expf(P.in[I_LDT][g]);
    if (tid < 64) {
        const int p = tid; const float lr = P.in[I_LRE][g * 64 + p], li = P.in[I_LIM][g * 64 + p];
        for (int tau = 0; tau <= 16; ++tau) { const float e = __expf(lr * dt * tau); float sn, cs; sincosf(li * dt * tau, &sn, &cs); Pw[(tau * 64 + p) * 2] = e * cs; Pw[(tau * 64 + p) * 2 + 1] = e * sn; }
        float* laml = (float*)(P.ws + WS_SMALL) + SM_LAML;
        laml[(g * 64 + p) * 2] = Pw[(16 * 64 + p) * 2]; laml[(g * 64 + p) * 2 + 1] = Pw[(16 * 64 + p) * 2 + 1];
    }
    for (int i = tid; i < 1024; i += 512) {
        const int p = i >> 4; const float lr = P.in[I_LRE][g * 64 + p], li = P.in[I_LIM][g * 64 + p];
        const float e = __expf(lr * dt); float sn, cs; sincosf(li * dt, &sn, &cs);
        const float nr = e * cs - 1.0f, ni = e * sn, den = 1.0f / (lr * lr + li * li);
        const float fr_ = (nr * lr + ni * li) * den, fi_ = (ni * lr - nr * li) * den;
        const float br = P.in[I_BRE][(size_t)g * 1024 + i], bi = P.in[I_BIM][(size_t)g * 1024 + i];
        Bb[i * 2] = fr_ * br - fi_ * bi; Bb[i * 2 + 1] = fr_ * bi + fi_ * br;
        Cc[i * 2] = P.in[I_CRE][(size_t)g * 1024 + i]; Cc[i * 2 + 1] = P.in[I_CIM][(size_t)g * 1024 + i];
    }
    __syncthreads();
    for (int i = tid; i < 4096; i += 512) {
        const int tau = i >> 8, h = (i >> 4) & 15, hp = i & 15; float s = 0.f;
        for (int p = 0; p < 64; ++p) {
            const float cr = Cc[(h * 64 + p) * 2], ci = Cc[(h * 64 + p) * 2 + 1], pr = Pw[(tau * 64 + p) * 2], pi = Pw[(tau * 64 + p) * 2 + 1];
            const float zr = cr * pr - ci * pi, zi = cr * pi + ci * pr;
            s += zr * Bb[(p * 16 + hp) * 2] - zi * Bb[(p * 16 + hp) * 2 + 1];
        }
        if (tau == 0 && h == hp) s += P.in[I_DSK][g * 16 + h];
        Kt[i] = s;
    }
    __syncthreads();
    bf16_t* btc = (bf16_t*)(P.ws + WS_BTC) + (size_t)g * 256 * 384;
    for (int i = tid; i < 256 * 48; i += 512) {
        const int n = i / 48, k0 = (i % 48) * 8, t = n >> 4, h = n & 15; float o[8];
#pragma unroll
        for (int e = 0; e < 8; ++e) {
            const int k = k0 + e;
            if (k < 256) { const int s = k >> 4, hp = k & 15; o[e] = (t >= s) ? Kt[((t - s) * 16 + h) * 16 + hp] : 0.f; }
            else { const int kk = k - 256, ri = kk >> 6, p = kk & 63; const float cr = Cc[(h * 64 + p) * 2], ci = Cc[(h * 64 + p) * 2 + 1], pr = Pw[((t + 1) * 64 + p) * 2], pi = Pw[((t + 1) * 64 + p) * 2 + 1];
                o[e] = ri == 0 ? (cr * pr - ci * pi) : -(cr * pi + ci * pr); }
        }
        u32x4 w; w.x = cvt_pk_bf16(o[0], o[1]); w.y = cvt_pk_bf16(o[2], o[3]); w.z = cvt_pk_bf16(o[4], o[5]); w.w = cvt_pk_bf16(o[6], o[7]);
        *(u32x4*)(btc + (size_t)n * 384 + k0) = w;
    }
    bf16_t* bte = (bf16_t*)(P.ws + WS_BTE) + (size_t)g * 128 * 256;
    for (int i = tid; i < 128 * 32; i += 512) {
        const int n = i >> 5, k0 = (i & 31) * 8, ri = n >> 6, p = n & 63; float o[8];
#pragma unroll
        for (int e = 0; e < 8; ++e) {
            const int k = k0 + e, s = k >> 4, hp = k & 15;
            const float pr = Pw[((15 - s) * 64 + p) * 2], pi = Pw[((15 - s) * 64 + p) * 2 + 1], br = Bb[(p * 16 + hp) * 2], bi = Bb[(p * 16 + hp) * 2 + 1];
            o[e] = ri == 0 ? (pr * br - pi * bi) : (pr * bi + pi * br);
        }
        u32x4 w; w.x = cvt_pk_bf16(o[0], o[1]); w.y = cvt_pk_bf16(o[2], o[3]); w.z = cvt_pk_bf16(o[4], o[5]); w.w = cvt_pk_bf16(o[6], o[7]);
        *(u32x4*)(bte + (size_t)n * 256 + k0) = w;
    }
    __syncthreads();
}

__device__ void phase_prep(const Params& P, LAS unsigned char* lds) {
    const int tid = threadIdx.x, bid = blockIdx.x, nb = gridDim.x;
    float* sm = (float*)(P.ws + WS_SMALL);
    for (int i = bid * 512 + tid; i < 49152 + 65536; i += nb * 512) sm[SM_SSQ1 + i] = 0.f;
    { bf16_t* wg = (bf16_t*)(P.ws + WS_WG);
      for (int i = bid * 512 + tid; i < 16 * 2048; i += nb * 512) { const int n = i >> 11, k = i & 2047; wg[i] = n < 8 ? f2bf(P.in[I_WIN][(size_t)k * INC + 3072 + n] * P.in[I_MIXN][k]) : (bf16_t)0; } }
    { const int w = tid >> 6, lane = tid & 63; bf16_t* xb = (bf16_t*)(P.ws + WS_XB);
      for (int row = bid * 8 + w; row < T_TOK; row += 2 * nb * 8) {
          const int row2 = row + nb * 8; const bool has2 = row2 < T_TOK;
          const float* xr = P.in[I_X] + (size_t)row * DM; const float* xr2 = P.in[I_X] + (size_t)(has2 ? row2 : row) * DM;
          f32x4 va[8], vb[8];
#pragma unroll
          for (int it = 0; it < 8; ++it) { va[it] = __builtin_nontemporal_load((const f32x4*)(xr + (it * 64 + lane) * 4)); vb[it] = __builtin_nontemporal_load((const f32x4*)(xr2 + (it * 64 + lane) * 4)); }
          float s = 0.f, s2 = 0.f;
#pragma unroll
          for (int it = 0; it < 8; ++it) { const f32x4 v = va[it], u = vb[it];
              s += v[0] * v[0] + v[1] * v[1] + v[2] * v[2] + v[3] * v[3]; s2 += u[0] * u[0] + u[1] * u[1] + u[2] * u[2] + u[3] * u[3];
              u32x2 o; o.x = cvt_pk_bf16(v[0], v[1]); o.y = cvt_pk_bf16(v[2], v[3]); *(u32x2*)(xb + (size_t)row * DM + (it * 64 + lane) * 4) = o;
              if (has2) { u32x2 o2; o2.x = cvt_pk_bf16(u[0], u[1]); o2.y = cvt_pk_bf16(u[2], u[3]); *(u32x2*)(xb + (size_t)row2 * DM + (it * 64 + lane) * 4) = o2; } }
#pragma unroll
          for (int o = 32; o >= 1; o >>= 1) { s += __shfl_xor(s, o); s2 += __shfl_xor(s2, o); }
          if (lane == 0) { sm[SM_SSQ0 + row] = s; if (has2) sm[SM_SSQ0 + row2] = s2; }
      } }
    for (int g = bid; g < 64; g += nb) s5_prep_group(P, lds, g);
    const int nskip = nb > 128 ? 64 : 0, nwk = nb - nskip;
    if (bid >= nskip)
    for (int t = bid - nskip; t < CVT_T_W13; t += 2 * nwk) {
        const CvtDesc d0 = cvt_decode(P, t); f32x4 v0[8]; float g0[8]; cvt_load(d0, v0, g0);
        if (t + nwk < CVT_T_W13) { const CvtDesc d1 = cvt_decode(P, t + nwk); f32x4 v1[8]; float g1[8]; cvt_load(d1, v1, g1); cvt_store(d0, v0, g0); cvt_store(d1, v1, g1); }
        else cvt_store(d0, v0, g0);
    }
}

__device__ void phase_gates(const Params& P, LAS unsigned char* lds) {
    const int tid = threadIdx.x, w = tid >> 6, lane = tid & 63, fr = lane & 15, fq = lane >> 4, half = w & 1;
    const bf16_t* xb = (const bf16_t*)(P.ws + WS_XB); const bf16_t* wg = (const bf16_t*)(P.ws + WS_WG);
    float* sm = (float*)(P.ws + WS_SMALL); LAS f32x4* xch = (LAS f32x4*)lds;
    for (int t0 = blockIdx.x * 4; t0 < T_TOK / 16; t0 += gridDim.x * 4) {
        const int task = t0 + (w >> 1); const bool valid = task < T_TOK / 16;
        const int tok0 = (valid ? task : 0) * 16; f32x4 acc = {0.f, 0.f, 0.f, 0.f};
        const bf16_t* ap = xb + (size_t)(tok0 + fr) * DM + half * 1024 + fq * 8; const bf16_t* bp = wg + (size_t)fr * DM + half * 1024 + fq * 8;
#pragma unroll 16
        for (int kk = 0; kk < 32; ++kk) { const bf16x8 a = *(const bf16x8*)(ap + kk * 32), b = *(const bf16x8*)(bp + kk * 32); acc = __builtin_amdgcn_mfma_f32_16x16x32_bf16(a, b, acc, 0, 0, 0); }
        __syncthreads();
        if (half) xch[(w >> 1) * 64 + lane] = acc;
        __syncthreads();
        if (!half && valid && fr < 8) {
            acc += xch[(w >> 1) * 64 + lane];
            const float bias = fr < 4 ? P.in[I_BI][fr] : P.in[I_BF][fr - 4];
#pragma unroll
            for (int j = 0; j < 4; ++j) { const int tok = tok0 + fq * 4 + j; float v = rs_of(sm[SM_SSQ1 + tok], 1.0f / DM) * acc[j] + bias;
                if (fr >= 4) v = fminf(v, 0.f) - log1pf(__expf(-fabsf(v)));
                sm[SM_GATES + (size_t)tok * 8 + fr] = v; }
        }
    }
}

__device__ void phase_s5_scan(const Params& P) {
    const int tid = threadIdx.x; if (tid >= 128) return;
    const float* __restrict__ E = (const float*)(P.ws + WS_E); bf16_t* __restrict__ UX = (bf16_t*)(P.ws + WS_UX); const float* laml = (const float*)(P.ws + WS_SMALL) + SM_LAML;
    for (int id = blockIdx.x * 128 + tid; id < 8 * 64 * 64; id += gridDim.x * 128) {
        const int p = id & 63, g = (id >> 6) & 63, b = id >> 12;
        const float lr = laml[(g * 64 + p) * 2], li = laml[(g * 64 + p) * 2 + 1]; float xr = 0.f, xi = 0.f;
        const size_t row0 = (size_t)g * 1024 + b * 128;
        for (int c0 = 0; c0 < 128; c0 += 16) {
            float er[16], ei[16];
#pragma unroll
            for (int c = 0; c < 16; ++c) { er[c] = E[(row0 + c0 + c) * 128 + p]; ei[c] = E[(row0 + c0 + c) * 128 + 64 + p]; }
#pragma unroll
            for (int c = 0; c < 16; ++c) {
                UX[(row0 + c0 + c) * 384 + 256 + p] = f2bf(xr); UX[(row0 + c0 + c) * 384 + 320 + p] = f2bf(xi);
                const float nr = lr * xr - li * xi + er[c], ni = lr * xi + li * xr + ei[c]; xr = nr; xi = ni;
            }
        }
    }
}

__device__ void phase_mix_pre(const Params& P, LAS unsigned char* lds) {
    const int tid = threadIdx.x, w = __builtin_amdgcn_readfirstlane(tid >> 6), lane = tid & 63, fr = lane & 15, fq = lane >> 4;
    LAS bf16_t* qs = (LAS bf16_t*)lds; LAS bf16_t* ks = (LAS bf16_t*)(lds + 17408); LAS float* fwp = (LAS float*)(lds + 34816);
    const float* gates = (const float*)(P.ws + WS_SMALL) + SM_GATES; bf16_t* SPg = (bf16_t*)(P.ws + WS_SP);
    const bf16_t* QK = (const bf16_t*)(P.ws + WS_QK); bf16_t* QKC = (bf16_t*)(P.ws + WS_QKC); bf16_t* KT = (bf16_t*)(P.ws + WS_KT);
    const int dg = tid & 31, isK = dg >> 4, d0 = (dg & 15) * 8, tl = tid >> 5;
    const float qscale = isK ? 1.0f : 0.08838834764831845f;
#define MP_LOAD_RAW(dst, tk) do { const int b_ = (tk) >> 7, h_ = ((tk) >> 5) & 3, t0_ = ((tk) & 31) * 64, cc_ = (isK ? 512 : 0) + h_ * 128 + d0; \
        _Pragma("unroll") for (int i_ = 0; i_ < 7; ++i_) { const int pos_ = t0_ + tl * 4 - 3 + i_; dst[i_] = pos_ >= 0 ? *(const u32x4*)(QK + ((size_t)b_ * SEQ + pos_) * 1024 + cc_) : (u32x4){0u, 0u, 0u, 0u}; } } while (0)
    float cw[4][8], cb[8]; int h_prev = -1;
    u32x4 raw[7];
    if ((int)blockIdx.x < 1024) MP_LOAD_RAW(raw, (int)blockIdx.x);
    for (int task = blockIdx.x; task < 1024; task += gridDim.x) {
        const int b = task >> 7, h = (task >> 5) & 3, c = task & 31, t0 = c * 64;
        const int convcol = (isK ? 512 : 0) + h * 128 + d0;
        if (h != h_prev) {
            h_prev = h;
#pragma unroll
            for (int j = 0; j < 4; ++j) { const f32x4 a0 = *(const f32x4*)(P.in[I_CONVW] + j * 1024 + convcol), a1 = *(const f32x4*)(P.in[I_CONVW] + j * 1024 + convcol + 4);
                cw[j][0] = a0[0]; cw[j][1] = a0[1]; cw[j][2] = a0[2]; cw[j][3] = a0[3]; cw[j][4] = a1[0]; cw[j][5] = a1[1]; cw[j][6] = a1[2]; cw[j][7] = a1[3]; }
            { const f32x4 a0 = *(const f32x4*)(P.in[I_CONVB] + convcol), a1 = *(const f32x4*)(P.in[I_CONVB] + convcol + 4);
                cb[0] = a0[0]; cb[1] = a0[1]; cb[2] = a0[2]; cb[3] = a0[3]; cb[4] = a1[0]; cb[5] = a1[1]; cb[6] = a1[2]; cb[7] = a1[3]; }
        }
        u32x4 nraw[7];
#pragma unroll
        for (int i = 0; i < 7; ++i) nraw[i] = (u32x4){0u, 0u, 0u, 0u};
        if (task + (int)gridDim.x < 1024) MP_LOAD_RAW(nraw, task + (int)gridDim.x);
        float o[4][8];
#pragma unroll
        for (int tt = 0; tt < 4; ++tt) {
#pragma unroll
            for (int e = 0; e < 8; ++e) o[tt][e] = cb[e];
#pragma unroll
            for (int j = 0; j < 4; ++j) { const u32x4 x = raw[tt + j];
                o[tt][0] += cw[j][0] * bf_lo(x.x); o[tt][1] += cw[j][1] * bf_hi(x.x); o[tt][2] += cw[j][2] * bf_lo(x.y); o[tt][3] += cw[j][3] * bf_hi(x.y);
                o[tt][4] += cw[j][4] * bf_lo(x.z); o[tt][5] += cw[j][5] * bf_hi(x.z); o[tt][6] += cw[j][6] * bf_lo(x.w); o[tt][7] += cw[j][7] * bf_hi(x.w); }
#pragma unroll
            for (int e = 0; e < 8; ++e) o[tt][e] = siluf_(o[tt][e]) * qscale;
            u32x4 wv; wv.x = cvt_pk_bf16(o[tt][0], o[tt][1]); wv.y = cvt_pk_bf16(o[tt][2], o[tt][3]); wv.z = cvt_pk_bf16(o[tt][4], o[tt][5]); wv.w = cvt_pk_bf16(o[tt][6], o[tt][7]);
            *(u32x4*)(QKC + ((size_t)b * SEQ + t0 + tl * 4 + tt) * 1024 + convcol) = wv;
            *(LAS u32x4*)((isK ? ks : qs) + (tl * 4 + tt) * 136 + d0) = wv;
        }
        if (isK) {
            bf16_t* kt = KT + (size_t)task * 8192 + tl * 4;
#pragma unroll
            for (int e = 0; e < 8; ++e) { u32x2 wv; wv.x = cvt_pk_bf16(o[0][e], o[1][e]); wv.y = cvt_pk_bf16(o[2][e], o[3][e]); *(u32x2*)(kt + (d0 + e) * 64) = wv; }
        }
        if (w == 0) {
            const size_t tok = (size_t)b * SEQ + t0 + lane; const float li = gates[tok * 8 + h]; float x = gates[tok * 8 + 4 + h];
#pragma unroll
            for (int off = 1; off < 64; off <<= 1) { const float t = __shfl_up(x, off); if (lane >= off) x += t; }
            const float wv = li - x; float pm = wv;
#pragma unroll
            for (int off = 1; off < 64; off <<= 1) { const float t = __shfl_up(pm, off); if (lane >= off) pm = fmaxf(pm, t); }
            fwp[lane] = wv; fwp[64 + lane] = pm;
        }
        __syncthreads();
        for (int idx = w; idx < 16; idx += 8) {
            bf16_t* spt = SPg + (size_t)task * 4096;
            if (idx < 10) {
                const int ti = (0xFFA94 >> (2 * idx)) & 3, si = (0xE4910 >> (2 * idx)) & 3;
                f32x4 sT = {0.f, 0.f, 0.f, 0.f};
#pragma unroll
                for (int kk = 0; kk < 4; ++kk) { const bf16x8 a = *(const LAS bf16x8*)(ks + (si * 16 + fr) * 136 + kk * 32 + fq * 8), bb = *(const LAS bf16x8*)(qs + (ti * 16 + fr) * 136 + kk * 32 + fq * 8);
                    sT = __builtin_amdgcn_mfma_f32_16x16x32_bf16(a, bb, sT, 0, 0, 0); }
                const int tr = ti * 16 + fr, sc0 = si * 16 + fq * 4; const float pmt = fwp[64 + tr];
                const f32x4 w4 = *(const LAS f32x4*)(fwp + sc0);
                float vv[4];
#pragma unroll
                for (int j = 0; j < 4; ++j) vv[j] = (sc0 + j <= tr) ? sT[j] * fexp(w4[j] - pmt) : 0.f;
                u32x2 pk; pk.x = cvt_pk_bf16(vv[0], vv[1]); pk.y = cvt_pk_bf16(vv[2], vv[3]);
                *(u32x2*)(spt + tr * 64 + sc0) = pk;
            } else {
                const int k = idx - 10, ti = (k >= 3) + (k >= 5), si = k < 3 ? k + 1 : (k < 5 ? k - 1 : 3);
                *(u32x2*)(spt + (ti * 16 + fr) * 64 + si * 16 + fq * 4) = (u32x2){0u, 0u};
            }
        }
        __syncthreads();
#pragma unroll
        for (int i = 0; i < 7; ++i) raw[i] = nraw[i];
    }
#undef MP_LOAD_RAW
}

#define LDS_BARRIER() do { asm volatile("s_waitcnt lgkmcnt(0)" ::: "memory"); __builtin_amdgcn_s_barrier(); asm volatile("" ::: "memory"); } while (0)
__device__ void mlstm_item(const Params& P, LAS unsigned char* lds, int item, float* ssqh) {
    const int tid = threadIdx.x, w = __builtin_amdgcn_readfirstlane(tid >> 6), lane = tid & 63, fr = lane & 15, fq = lane >> 4;
    const int pair = (item & 7) * 4 + (item >> 6), js = (item >> 3) & 7, b = pair >> 2, h = pair & 3;
    LAS bf16_t* qs = (LAS bf16_t*)(lds);
    LAS bf16_t* ks = (LAS bf16_t*)(lds + 17408);
    LAS bf16_t* kT = (LAS bf16_t*)(lds + 34816);
    LAS bf16_t* vT = (LAS bf16_t*)(lds + 53248);
    LAS bf16_t* vTd = (LAS bf16_t*)(lds + 60160);
    LAS bf16_t* Sp = (LAS bf16_t*)(lds + 67072);
    LAS bf16_t* Cb = (LAS bf16_t*)(lds + 76288);
    LAS float* fw = (LAS float*)(lds + 89344);
    LAS float* fM = fw + 64; LAS float* fa = fw + 128; LAS float* fen = fw + 192; LAS float* fd63 = fw + 256;
    const bf16_t* QKC = (const bf16_t*)(P.ws + WS_QKC); const bf16_t* KT = (const bf16_t*)(P.ws + WS_KT); const bf16_t* SPt = (const bf16_t*)(P.ws + WS_SP); const bf16_t* V = (const bf16_t*)(P.ws + WS_V); bf16_t* MIX = (bf16_t*)(P.ws + WS_MIX);
    const float* gates = (const float*)(P.ws + WS_SMALL) + SM_GATES;
    __syncthreads();
    for (int i = tid; i < 64 * 72; i += 512) Sp[i] = 0;
    for (int i = tid; i < 16 * 72; i += 512) { const bf16_t v = (i < 72) ? (bf16_t)0x3F80 : (bf16_t)0; vT[32 * 72 + i] = v; vTd[32 * 72 + i] = 0; }
    const int qrow = tid >> 4, qch = (tid & 15) * 8, ktrow = tid >> 3, ktch = (tid & 7) * 8, task0 = (b * 4 + h) * 32;
    f32x4 Cacc[3][2];
#pragma unroll
    for (int a = 0; a < 3; ++a)
#pragma unroll
        for (int c2 = 0; c2 < 2; ++c2) Cacc[a][c2] = (f32x4){0.f, 0.f, 0.f, 0.f};
    float m_prev = 0.f;
    LAS float* gsl = (LAS float*)(lds + 90624);
    for (int cc = w; cc < 32; cc += 8) {
        const size_t tok = (size_t)b * SEQ + cc * 64 + lane;
        const float li = gates[tok * 8 + h]; float x = gates[tok * 8 + 4 + h];
#pragma unroll
        for (int off = 1; off < 64; off <<= 1) { const float t = __shfl_up(x, off); if (lane >= off) x += t; }
        const float wv = li - x; float pm = wv;
#pragma unroll
        for (int off = 1; off < 64; off <<= 1) { const float t = __shfl_up(pm, off); if (lane >= off) pm = fmaxf(pm, t); }
        gsl[cc * 192 + lane] = wv; gsl[cc * 192 + 64 + lane] = pm; gsl[cc * 192 + 128 + lane] = x;
    }
    __syncthreads();
    u32x4 rq[2], rkt[2], rsp; u32x4 vraw = {0u, 0u, 0u, 0u};
    const int vs = (tid >> 2) & 63, vcg = tid & 3;
#define ML_PREFETCH(cc) do { const size_t tbn_ = (size_t)b * SEQ + (cc) * 64; const int task_ = task0 + (cc); \
        _Pragma("unroll") for (int i_ = 0; i_ < 2; ++i_) { rq[i_] = *(const u32x4*)(QKC + (tbn_ + qrow + 32 * i_) * 1024 + h * 128 + qch); \
            rkt[i_] = *(const u32x4*)(KT + (size_t)task_ * 8192 + (ktrow + 64 * i_) * 64 + ktch); } \
        rsp = *(const u32x4*)(SPt + (size_t)task_ * 4096 + tid * 8); \
        if (w >= 4) vraw = *(const u32x4*)(V + (tbn_ + vs) * 1024 + h * 256 + js * 32 + vcg * 8); \
        } while (0)
    ML_PREFETCH(0);
    const CvtDesc cvdflt = cvt_decode(P, CVT_EARLY);
    CvtDesc cvdA = cvdflt, cvdB = cvdflt; f32x4 cvvA[4], cvvB[4]; f32x4 cvgA, cvgB; bool pendA = false, pendB = false;
    u32x2 hold0 = {0u, 0u}, hold1 = {0u, 0u}; bf16_t* hold_dst = MIX;
    auto chunk_body = [&](const int c, CvtDesc& cvd, f32x4 (&cvv)[4], f32x4& cvg, bool& cv_pend) __attribute__((always_inline)) {
        const int t0 = c * 64; const size_t tokbase = (size_t)b * SEQ + t0;
#pragma unroll
        for (int i = 0; i < 2; ++i) { *(LAS u32x4*)(qs + (qrow + 32 * i) * 136 + qch) = rq[i]; *(LAS u32x4*)(kT + (ktrow + 64 * i) * 72 + ktch) = rkt[i]; }
        *(LAS u32x4*)(Sp + (tid >> 3) * 72 + (tid & 7) * 8) = rsp;
        const LAS float* gc = gsl + c * 192;
        const float M63 = fmaxf(m_prev, gc[127]), a63 = fexp(m_prev - M63), m_next = gc[191] + M63;
        if (w >= 4) {
            LAS bf16_t* d = vT + (vcg * 8) * 72 + vs;
            d[0] = (bf16_t)(vraw.x & 0xffff); d[72] = (bf16_t)(vraw.x >> 16); d[144] = (bf16_t)(vraw.y & 0xffff); d[216] = (bf16_t)(vraw.y >> 16);
            d[288] = (bf16_t)(vraw.z & 0xffff); d[360] = (bf16_t)(vraw.z >> 16); d[432] = (bf16_t)(vraw.w & 0xffff); d[504] = (bf16_t)(vraw.w >> 16);
            { const float d = fexp(gc[vs] - M63); LAS bf16_t* dd = vTd + (vcg * 8) * 72 + vs;
              dd[0] = f2bf(bf_lo(vraw.x) * d); dd[72] = f2bf(bf_hi(vraw.x) * d); dd[144] = f2bf(bf_lo(vraw.y) * d); dd[216] = f2bf(bf_hi(vraw.y) * d);
              dd[288] = f2bf(bf_lo(vraw.z) * d); dd[360] = f2bf(bf_hi(vraw.z) * d); dd[432] = f2bf(bf_lo(vraw.w) * d); dd[504] = f2bf(bf_hi(vraw.w) * d);
              if (vcg == 0) vTd[32 * 72 + vs] = f2bf(d); }
#pragma unroll
            for (int vt = 0; vt < 3; ++vt)
#pragma unroll
                for (int k2 = 0; k2 < 2; ++k2) { u32x2 pk; pk.x = cvt_pk_bf16(Cacc[vt][k2][0], Cacc[vt][k2][1]); pk.y = cvt_pk_bf16(Cacc[vt][k2][2], Cacc[vt][k2][3]);
                    *(LAS u32x2*)(Cb + (vt * 16 + fr) * 136 + ((w - 4) * 2 + k2) * 16 + fq * 4) = pk; }
        }
        if (cv_pend) cvt_store4(cvd, cvv, cvg);
        if (w < 4 && c > 0) { *(u32x2*)hold_dst = hold0; *(u32x2*)(hold_dst + 16) = hold1; }
        if (c + 1 < 32) ML_PREFETCH(c + 1);
        {
          const int cvt_h = c * (int)gridDim.x + (int)blockIdx.x; cv_pend = cvt_h < 2 * (CVT_TOT - CVT_EARLY);
          if (cv_pend) { cvd = cvt_decode(P, CVT_EARLY + (cvt_h >> 1)); cvd.k0 += (cvt_h & 1) * 128; } else cvd = cvdflt;
          cvt_load4(cvd, cvv, cvg); }
        LDS_BARRIER();
        f32x4 o2[3];
        if (w < 4) {
#pragma unroll
            for (int vt = 0; vt < 3; ++vt) o2[vt] = (f32x4){0.f, 0.f, 0.f, 0.f};
#pragma unroll
            for (int kk = 0; kk < 4; ++kk) { const bf16x8 bb = *(const LAS bf16x8*)(qs + (w * 16 + fr) * 136 + kk * 32 + fq * 8);
#pragma unroll
                for (int vt = 0; vt < 3; ++vt) { const bf16x8 a = *(const LAS bf16x8*)(Cb + (vt * 16 + fr) * 136 + kk * 32 + fq * 8); o2[vt] = __builtin_amdgcn_mfma_f32_16x16x32_bf16(a, bb, o2[vt], 0, 0, 0); } }
        }
        if (w < 4) {
            const int ti = w; f32x4 o1[3];
#pragma unroll
            for (int vt = 0; vt < 3; ++vt) o1[vt] = (f32x4){0.f, 0.f, 0.f, 0.f};
#pragma unroll
            for (int kk = 0; kk < 2; ++kk) { const bf16x8 bb = *(const LAS bf16x8*)(Sp + (ti * 16 + fr) * 72 + kk * 32 + fq * 8);
#pragma unroll
                for (int vt = 0; vt < 3; ++vt) { const bf16x8 a = *(const LAS bf16x8*)(vT + (vt * 16 + fr) * 72 + kk * 32 + fq * 8); o1[vt] = __builtin_amdgcn_mfma_f32_16x16x32_bf16(a, bb, o1[vt], 0, 0, 0); } }
            {
                const int tr = ti * 16 + fr; const float Mt = fmaxf(m_prev, gc[64 + tr]); const float at = fexp(m_prev - Mt), en = fexp(-(gc[128 + tr] + Mt)), ft = fexp(gc[64 + tr] - Mt);
#pragma unroll
                for (int vt = 0; vt < 3; ++vt) o1[vt] = o1[vt] * ft;
                const float dn = o1[2][0] + at * o2[2][0]; const float den = __shfl(dn, fr);
                const float inv = frcp(fmaxf(fabsf(den), en));
                hold_dst = MIX + (tokbase + tr) * 2048 + h * 256 + js * 32 + fq * 4;
                hold0.x = cvt_pk_bf16((o1[0][0] + at * o2[0][0]) * inv, (o1[0][1] + at * o2[0][1]) * inv); hold0.y = cvt_pk_bf16((o1[0][2] + at * o2[0][2]) * inv, (o1[0][3] + at * o2[0][3]) * inv);
                hold1.x = cvt_pk_bf16((o1[1][0] + at * o2[1][0]) * inv, (o1[1][1] + at * o2[1][1]) * inv); hold1.y = cvt_pk_bf16((o1[1][2] + at * o2[1][2]) * inv, (o1[1][3] + at * o2[1][3]) * inv);
            }
        } else {
#pragma unroll
            for (int vt = 0; vt < 3; ++vt)
#pragma unroll
                for (int k2 = 0; k2 < 2; ++k2) Cacc[vt][k2] = Cacc[vt][k2] * a63;
#pragma unroll
            for (int kk = 0; kk < 2; ++kk) {
                bf16x8 a[3], bb[2];
#pragma unroll
                for (int vt = 0; vt < 3; ++vt) a[vt] = *(const LAS bf16x8*)(vTd + (vt * 16 + fr) * 72 + kk * 32 + fq * 8);
#pragma unroll
                for (int k2 = 0; k2 < 2; ++k2) bb[k2] = *(const LAS bf16x8*)(kT + (((w - 4) * 2 + k2) * 16 + fr) * 72 + kk * 32 + fq * 8);
#pragma unroll
                for (int vt = 0; vt < 3; ++vt)
#pragma unroll
                    for (int k2 = 0; k2 < 2; ++k2) Cacc[vt][k2] = __builtin_amdgcn_mfma_f32_16x16x32_bf16(bb[k2], a[vt], Cacc[vt][k2], 0, 0, 0);
            }
        }
        m_prev = m_next;
        LDS_BARRIER();
        };
    for (int c2 = 0; c2 < 16; ++c2) { chunk_body(2 * c2, cvdA, cvvA, cvgA, pendA); chunk_body(2 * c2 + 1, cvdB, cvvB, cvgB, pendB); }
    if (pendA) cvt_store4(cvdA, cvvA, cvgA);
    if (pendB) cvt_store4(cvdB, cvvB, cvgB);
    if (w < 4) { *(u32x2*)hold_dst = hold0; *(u32x2*)(hold_dst + 16) = hold1; }
#undef ML_PREFETCH
}

__device__ void phase_hm_finalize(const Params& P) {
    bf16_t* MIX = (bf16_t*)(P.ws + WS_MIX); const bf16_t* O = (const bf16_t*)(P.ws + WS_O);
    const float* gn = P.in[I_MLN];
    for (size_t i = (size_t)blockIdx.x * 512 + threadIdx.x; i < (size_t)T_TOK * 128; i += (size_t)gridDim.x * 512) {
        const size_t t = i >> 7; const int c = (int)(i & 127) * 8;
        const u32x4 hv = *(const u32x4*)(MIX + t * 2048 + c), ov = *(const u32x4*)(O + t * 1024 + c);
        const f32x4 g0 = *(const f32x4*)(gn + c), g1 = *(const f32x4*)(gn + c + 4);
        const float h0 = bf_lo(hv.x), h1 = bf_hi(hv.x), h2 = bf_lo(hv.y), h3 = bf_hi(hv.y), h4 = bf_lo(hv.z), h5 = bf_hi(hv.z), h6 = bf_lo(hv.w), h7 = bf_hi(hv.w);
        float ss = h0 * h0 + h1 * h1 + h2 * h2 + h3 * h3 + h4 * h4 + h5 * h5 + h6 * h6 + h7 * h7;
        ss += __shfl_xor(ss, 1); ss += __shfl_xor(ss, 2); ss += __shfl_xor(ss, 4); ss += __shfl_xor(ss, 8); ss += __shfl_xor(ss, 16);
        const float rs = rs_of(ss, 1.0f / 256.0f);
        u32x4 w;
        w.x = cvt_pk_bf16(h0 * rs * g0[0] * bf_lo(ov.x), h1 * rs * g0[1] * bf_hi(ov.x));
        w.y = cvt_pk_bf16(h2 * rs * g0[2] * bf_lo(ov.y), h3 * rs * g0[3] * bf_hi(ov.y));
        w.z = cvt_pk_bf16(h4 * rs * g1[0] * bf_lo(ov.z), h5 * rs * g1[1] * bf_hi(ov.z));
        w.w = cvt_pk_bf16(h6 * rs * g1[2] * bf_lo(ov.w), h7 * rs * g1[3] * bf_hi(ov.w));
        *(u32x4*)(MIX + t * 2048 + c) = w;
    }
}
__device__ void phase_final_norm(const Params& P) {
    const float* ssq = (const float*)(P.ws + WS_SMALL) + SM_SSQ3; const float* gn = P.in[I_FINN]; const bf16_t* XBp = (const bf16_t*)(P.ws + WS_XB);
#pragma unroll 2
    for (size_t i = (size_t)blockIdx.x * 512 + threadIdx.x; i < (size_t)T_TOK * 256; i += (size_t)gridDim.x * 512) {
        const size_t t = i >> 8; const int c = (int)(i & 255) * 8;
        const float rs = rs_of(ssq[t], 1.0f / DM);
        const u32x4 xv = *(const u32x4*)(XBp + t * DM + c); const f32x4 g0 = *(const f32x4*)(gn + c), g1 = *(const f32x4*)(gn + c + 4);
        const f32x4 o0 = {bf_lo(xv.x) * rs * g0[0], bf_hi(xv.x) * rs * g0[1], bf_lo(xv.y) * rs * g0[2], bf_hi(xv.y) * rs * g0[3]};
        const f32x4 o1 = {bf_lo(xv.z) * rs * g1[0], bf_hi(xv.z) * rs * g1[1], bf_lo(xv.w) * rs * g1[2], bf_hi(xv.w) * rs * g1[3]};
        *(f32x4*)(P.out + t * DM + c) = o0; *(f32x4*)(P.out + t * DM + c + 4) = o1;
    }
}

struct EpiE { float* E; __device__ __forceinline__ void operator()(int r, int c, const f32x4& v) const { *(f32x4*)(E + (size_t)r * 128 + c) = v; } };
struct EpiY { bf16_t* YS; int g, nt; __device__ __forceinline__ void operator()(int r, int c, const f32x4& v) const {
    const int n = nt * 128 + c, t = n >> 4, h = n & 15; u32x2 w; w.x = cvt_pk_bf16(gelu_tanh(v[0]), gelu_tanh(v[1])); w.y = cvt_pk_bf16(gelu_tanh(v[2]), gelu_tanh(v[3]));
    *(u32x2*)(YS + ((size_t)r * 16 + t) * 1024 + g * 16 + h) = w; } };

#define PROBE 0
#define DUP_P1 0
#define DUP_MLSTM 0
#define PROBE_AMASK 0xFFF
#define PROBE_BMASK 0x001
#if PROBE
#define TS(i) do { if (blockIdx.x == 0 && threadIdx.x == 0) ((unsigned long long*)(P.ws + WS_SMALL) + SM_ENDF)[i] = __builtin_amdgcn_s_memrealtime(); } while (0)
#else
#define TS(i) do { } while (0)
#endif
#define XB_TMO      128
#define XB_XCNT(j)  (256  + 64 * (j))
#define XB_XSUB(j)  (1280 + 64 * (j))
#define XB_XGEN(j)  (2304 + 64 * (j))
#define XB_TOP      3328
#define XB_TOPGEN   3392
#define XCD_BAR_WORDS 3456
#define XB_SPIN_CAP (1u << 18)

__device__ __forceinline__ unsigned xb_ld(unsigned* p)              { return __hip_atomic_load(p, __ATOMIC_RELAXED, __HIP_MEMORY_SCOPE_AGENT); }
__device__ __forceinline__ unsigned xb_add(unsigned* p, unsigned v) { return __hip_atomic_fetch_add(p, v, __ATOMIC_RELAXED, __HIP_MEMORY_SCOPE_AGENT); }
__device__ __forceinline__ unsigned xb_xcc_id() { return (unsigned)__builtin_amdgcn_s_getreg((3 << 11) | 20) & 0xFu; }
#define XB_SPIN(cond, bar) do { unsigned _sp = 0; while (cond) { __builtin_amdgcn_s_sleep(1); \
    if ((++_sp & 255u) == 0u) { if (xb_ld(&(bar)[XB_TMO])) break; if (_sp > XB_SPIN_CAP) { atomicAdd(&(bar)[XB_TMO], 1u); break; } } } } while (0)

struct XcdBarrier {
    unsigned* bar; unsigned x;
    volatile LAS unsigned* st;
};

__device__ __forceinline__ XcdBarrier xcd_barrier_post(unsigned* bar, volatile LAS unsigned* st) {
    XcdBarrier b; b.bar = bar; b.x = xb_xcc_id(); b.st = st;
    if (threadIdx.x == 0) (void)xb_add(&bar[XB_XCNT(b.x)], 1u);
    return b;
}
__device__ __forceinline__ void xcd_barrier_complete(unsigned* bar, unsigned x, unsigned& nloc, unsigned& nx) {
    const unsigned G = gridDim.x * gridDim.y * gridDim.z;
    unsigned sum, cnt, mine, sp = 0u;
    for (;;) {
        sum = 0u; cnt = 0u; mine = 0u;
#pragma unroll
        for (unsigned j = 0; j < 16; ++j) { const unsigned c = xb_ld(&bar[XB_XCNT(j)]); sum += c; cnt += (c > 0u) ? 1u : 0u; mine = (j == x) ? c : mine; }
        if (sum == G) break;
        __builtin_amdgcn_s_sleep(1);
        if ((++sp & 255u) == 0u) { if (xb_ld(&bar[XB_TMO])) break; if (sp > XB_SPIN_CAP) { atomicAdd(&bar[XB_TMO], 1u); break; } }
    }
    nloc = mine > 0u ? mine : 1u; nx = cnt > 0u ? cnt : 1u;
}

__device__ __forceinline__ void xcd_barrier(const XcdBarrier& b) {
    asm volatile("s_waitcnt vmcnt(0)" ::: "memory");
    __syncthreads();
    if (threadIdx.x == 0) {
        unsigned* bar = b.bar;
        __builtin_amdgcn_s_waitcnt(0);
        unsigned nloc = b.st[0], nx = b.st[1];
        if (nloc == 0u) { xcd_barrier_complete(bar, b.x, nloc, nx); b.st[0] = nloc; b.st[1] = nx; }
        const unsigned old = xb_add(&bar[XB_XSUB(b.x)], 1u);
        const unsigned gen = old / nloc;
        if (old + 1u == (gen + 1u) * nloc) {
            __builtin_amdgcn_fence(__ATOMIC_RELEASE, "agent");
            asm volatile("s_waitcnt vmcnt(0)" ::: "memory");
            const unsigned og = xb_add(&bar[XB_TOP], 1u);
            const unsigned tg = og / nx;
            if (og + 1u == (tg + 1u) * nx) xb_add(&bar[XB_TOPGEN], 1u);
            else XB_SPIN(xb_ld(&bar[XB_TOPGEN]) == tg, bar);
            __builtin_amdgcn_fence(__ATOMIC_ACQUIRE, "agent");
            xb_add(&bar[XB_XGEN(b.x)], 1u);
            asm volatile("s_waitcnt vmcnt(0)" ::: "memory");
        } else {
            XB_SPIN(xb_ld(&bar[XB_XGEN(b.x)]) == gen, bar);
            __builtin_amdgcn_fence(__ATOMIC_ACQUIRE, "agent");
            asm volatile("s_waitcnt vmcnt(0)" ::: "memory");
        }
    }
    __syncthreads();
}


#define GRID_SYNC_CG() do { asm volatile("s_waitcnt vmcnt(0) lgkmcnt(0)" ::: "memory"); grid.sync(); } while (0)
#define GRID_SYNC() xcd_barrier(xb)
__global__ void __launch_bounds__(512, 2) fwd_megakernel(Params P) {
    extern __shared__ __attribute__((aligned(16))) unsigned char shm_raw[];
    LAS unsigned char* lds = (LAS unsigned char*)shm_raw;
    cg::grid_group grid = cg::this_grid();
    float* sm = (float*)(P.ws + WS_SMALL);
    bf16_t* XB = (bf16_t*)(P.ws + WS_XB); bf16_t* G = (bf16_t*)(P.ws + WS_G); bf16_t* MIX = (bf16_t*)(P.ws + WS_MIX);
    pg8::StaticOrder S;
    volatile LAS unsigned* xst = (volatile LAS unsigned*)(lds + 131072);
    if (threadIdx.x < 2) xst[threadIdx.x] = 0u;
    __syncthreads();
    const XcdBarrier xb = xcd_barrier_post((unsigned*)(P.ws + WS_BAR), xst);
    TS(0);
    phase_prep(P, lds);
    if (P.out == nullptr) GRID_SYNC_CG();
    GRID_SYNC(); TS(1);
    { pg8::Gemm g{XB, (const bf16_t*)(P.ws + WS_W13_1), T_TOK, 2 * DFF, DM, DM, DM}; S.init(g.M, g.N, gridDim.x, blockIdx.x);
      EpiSwiGLU e{G, sm + SM_SSQ0, P.in[I_F1W2], P.in[I_WIN], P.in[I_MIXN], P.ws}; pg8::gemm_phase(lds, g, S, e);
#if DUP_P1
      __syncthreads(); pg8::gemm_phase(lds, g, S, e);
#endif
    }
    GRID_SYNC(); TS(2);
    { pg8::Gemm g{G, (const bf16_t*)(P.ws + WS_W2_1), T_TOK, DM, DFF, DFF, DFF}; S.init(g.M, g.N, gridDim.x, blockIdx.x);
      EpiResid<true> e{nullptr, XB, sm + SM_SSQ1, 0.5f}; pg8::gemm_phase(lds, g, S, e); }
    GRID_SYNC(); TS(3);
    { pg8::Gemm g{XB, (const bf16_t*)(P.ws + WS_WIN), T_TOK, 4096, DM, DM, DM}; S.init(g.M, g.N, gridDim.x, blockIdx.x);
      EpiWin e{(bf16_t*)(P.ws + WS_QK), (bf16_t*)(P.ws + WS_V), (bf16_t*)(P.ws + WS_O), (bf16_t*)(P.ws + WS_UX), sm + SM_SSQ1}; pg8::gemm_phase(lds, g, S, e); }
    phase_gates(P, lds);
    GRID_SYNC(); TS(4);
    phase_mix_pre(P, lds);
    __syncthreads();
    for (int id = blockIdx.x; id < 512; id += gridDim.x) { const int g = id >> 3, mt = id & 7;
        EpiE e{(float*)(P.ws + WS_E) + ((size_t)g * 1024 + mt * 128) * 128};
        sgemm_unit(lds, (const bf16_t*)(P.ws + WS_UX) + ((size_t)g * 1024 + mt * 128) * 384, 384, (const bf16_t*)(P.ws + WS_BTE) + (size_t)g * 128 * 256, 256, 256, e); }
    GRID_SYNC(); TS(5);
    phase_s5_scan(P);
    for (int it = blockIdx.x; it < 256; it += gridDim.x) mlstm_item(P, lds, it, sm + SM_SSQH);
#if DUP_MLSTM
    phase_s5_scan(P);
    for (int it = blockIdx.x; it < 256; it += gridDim.x) mlstm_item(P, lds, it, sm + SM_ENDF + 1024);
#endif
    GRID_SYNC(); TS(6);
    for (int id = blockIdx.x; id < 1024; id += gridDim.x) { const int g = id >> 4, mt = (id >> 1) & 7, nt = id & 1;
        EpiY e{(bf16_t*)(P.ws + WS_YS) + (size_t)(mt * 128) * 16 * 1024, g, nt};
        sgemm_unit(lds, (const bf16_t*)(P.ws + WS_UX) + ((size_t)g * 1024 + mt * 128) * 384, 384, (const bf16_t*)(P.ws + WS_BTC) + ((size_t)g * 256 + nt * 128) * 384, 384, 384, e); }
    phase_hm_finalize(P);
    GRID_SYNC(); TS(7);
    { pg8::Gemm g{(const bf16_t*)(P.ws + WS_YS), (const bf16_t*)(P.ws + WS_WGLU), T_TOK, 1024, 1024, 1024, 1024}; S.init(g.M, g.N, gridDim.x, blockIdx.x);
      EpiGLU e{(const bf16_t*)(P.ws + WS_YS), MIX, P.in[I_BGLU]}; pg8::gemm_phase(lds, g, S, e); }
    GRID_SYNC(); TS(8);
    { pg8::Gemm g{MIX, (const bf16_t*)(P.ws + WS_WOUT), T_TOK, DM, DM, DM, DM}; S.init(g.M, g.N, gridDim.x, blockIdx.x);
      EpiResid<true> e{nullptr, XB, sm + SM_SSQ2, 1.0f}; pg8::gemm_phase(lds, g, S, e); }
    GRID_SYNC(); TS(9);
    { pg8::Gemm g{XB, (const bf16_t*)(P.ws + WS_W13_2), T_TOK, 2 * DFF, DM, DM, DM}; S.init(g.M, g.N, gridDim.x, blockIdx.x);
      EpiSwiGLU e{G, sm + SM_SSQ2, nullptr, nullptr, nullptr, nullptr}; pg8::gemm_phase(lds, g, S, e); }
    GRID_SYNC(); TS(10);
    { pg8::Gemm g{G, (const bf16_t*)(P.ws + WS_W2_2), T_TOK, DM, DFF, DFF, DFF}; S.init(g.M, g.N, gridDim.x, blockIdx.x);
      EpiResid<true> e{nullptr, XB, sm + SM_SSQ3, 0.5f}; pg8::gemm_phase(lds, g, S, e); }
    GRID_SYNC(); TS(11);
    phase_final_norm(P);
#if PROBE
    GRID_SYNC(); TS(12);
    if (blockIdx.x == 0 && threadIdx.x == 0) {
        float sa = 0.f, sb = 0.f; const unsigned long long* tsv = (const unsigned long long*)(P.ws + WS_SMALL) + SM_ENDF;
        const int amask = PROBE_AMASK, bmask = PROBE_BMASK;
#pragma unroll
        for (int i = 0; i < 12; ++i) { const float d = (float)(tsv[i + 1] - tsv[i]) * 0.01f; if ((amask >> i) & 1) sa += d; if ((bmask >> i) & 1) sb += d; }
        P.out[0] += sa; for (int i = 1; i <= 100; ++i) P.out[i] += sb;
    }
#endif
}

extern "C" void kernel_launch(void* const* d_in, const int* in_sizes, int n_in, void* d_out, int out_size, void* d_ws, size_t ws_size, hipStream_t stream) {
    static int grid = 0;
    if (grid == 0) {
        if (n_in != 28 || ws_size < WS_END) { fprintf(stderr, "kernel_launch: unexpected n_in %d / ws_size %zu (need %zu)\n", n_in, ws_size, (size_t)WS_END); grid = -1; return; }
        int dev = 0, cus = 0, per_cu = 0;
        hipGetDevice(&dev); hipDeviceGetAttribute(&cus, hipDeviceAttributeMultiprocessorCount, dev);
        if (hipFuncSetAttribute((const void*)fwd_megakernel, hipFuncAttributeMaxDynamicSharedMemorySize, LDS_BYTES) != hipSuccess) { fprintf(stderr, "kernel_launch: hipFuncSetAttribute failed\n"); grid = -1; return; }
        if (hipOccupancyMaxActiveBlocksPerMultiprocessor(&per_cu, (const void*)fwd_megakernel, 512, LDS_BYTES) != hipSuccess || per_cu < 1) { fprintf(stderr, "kernel_launch: occupancy query gave %d\n", per_cu); per_cu = 1; }
        (void)hipGetLastError();
        grid = cus;
        if (grid > 256) grid = 256;
    }
    if (grid < 0) return;
    Params p{};
    for (int i = 0; i < 28; ++i) p.in[i] = (const float*)d_in[i];
    p.out = (float*)d_out; p.ws = (unsigned char*)d_ws;
    if (hipMemsetAsync((char*)d_ws + WS_BAR, 0, XCD_BAR_WORDS * sizeof(unsigned), stream) != hipSuccess) { fprintf(stderr, "kernel_launch: memset of barrier words failed\n"); return; }
    void* args[] = {&p};
    hipError_t e = hipLaunchCooperativeKernel((const void*)fwd_megakernel, dim3(grid), dim3(512), args, LDS_BYTES, stream);
    if (e != hipSuccess) fprintf(stderr, "cooperative launch failed: %s (grid %d)\n", hipGetErrorString(e), grid);
}
```
